# Optimizing an MI355X kernel written in HIP

```python
import jax, jax.numpy as jnp
from jax import lax
import numpy as np

D_MODEL = 4096
BATCH = 2
SEQ = 8192
DEPTH = 1

MLA_HEADS = 16
QK_NOPE_DIM = 128
QK_ROPE_DIM = 64
V_HEAD_DIM = 128
Q_LORA_RANK = 768
KV_LORA_RANK = 512
MLA_WIDTH = MLA_HEADS * V_HEAD_DIM
ROPE_THETA = 10000.0
Q_BLOCK = 128

HG_HEADS = 16
HG_KEY_DIM = 128
HG_VAL_DIM = 128
HG_FORGET_WIDTH = HG_HEADS * HG_KEY_DIM
HG_WIDTH = HG_HEADS * HG_VAL_DIM
HG_CHUNK = 64

MIX_WIDTH = MLA_WIDTH + HG_WIDTH
IN_SPLITS = (Q_LORA_RANK, KV_LORA_RANK, QK_ROPE_DIM,
             HG_FORGET_WIDTH, HG_FORGET_WIDTH, HG_WIDTH, HG_WIDTH)
N_IN = Q_LORA_RANK + KV_LORA_RANK + QK_ROPE_DIM + 2 * HG_FORGET_WIDTH + 2 * HG_WIDTH

D_FF = 11008
CONV_WIDTH = 3

EPS = 1e-6

kernel_name = "hybrid_mla_hgrn2_convglu_block"


def rms_norm(x, g):
    xf = x.astype(jnp.float32)
    y = xf * lax.rsqrt(jnp.mean(xf * xf, axis=-1, keepdims=True) + EPS)
    return (y * g.astype(jnp.float32)).astype(x.dtype)


def rope_cos_sin(positions):
    half = QK_ROPE_DIM // 2
    inv_freq = 1.0 / (ROPE_THETA ** (jnp.arange(half, dtype=jnp.float32) * 2.0 / QK_ROPE_DIM))
    ang = positions.astype(jnp.float32)[..., None] * inv_freq
    return jnp.cos(ang), jnp.sin(ang)


def apply_rope(x, cos, sin):
    half = QK_ROPE_DIM // 2
    xf = x.astype(jnp.float32)
    x1, x2 = xf[..., :half], xf[..., half:]
    return jnp.concatenate([x1 * cos - x2 * sin, x2 * cos + x1 * sin], axis=-1).astype(x.dtype)


def causal_block_attention(q_nope, q_rope, k_nope, k_rope, v):
    B, S, H, _ = q_nope.shape
    n_blocks = S // Q_BLOCK
    scale = (QK_NOPE_DIM + QK_ROPE_DIM) ** -0.5
    key_pos = jnp.arange(S)

    def block(i):
        start = i * Q_BLOCK
        qn = lax.dynamic_slice_in_dim(q_nope, start, Q_BLOCK, axis=1)
        qr = lax.dynamic_slice_in_dim(q_rope, start, Q_BLOCK, axis=1)
        s = (jnp.einsum('bqhd,bkhd->bhqk', qn, k_nope)
             + jnp.einsum('bqhr,bkr->bhqk', qr, k_rope)).astype(jnp.float32) * scale
        q_pos = start + jnp.arange(Q_BLOCK)
        mask = key_pos[None, :] <= q_pos[:, None]
        s = jnp.where(mask[None, None], s, -jnp.inf)
        p = jax.nn.softmax(s, axis=-1).astype(v.dtype)
        return jnp.einsum('bhqk,bkhd->bqhd', p, v)

    out = lax.map(block, jnp.arange(n_blocks))
    return out.transpose(1, 0, 2, 3, 4).reshape(B, S, H, V_HEAD_DIM)


def mla_mixer(c_q, c_kv, k_rope, cos, sin, q_norm_g, w_uq, kv_norm_g, w_ukv, out_norm_g):
    B, S, _ = c_q.shape
    q = (rms_norm(c_q, q_norm_g) @ w_uq).reshape(B, S, MLA_HEADS, QK_NOPE_DIM + QK_ROPE_DIM)
    q_nope, q_rope = q[..., :QK_NOPE_DIM], q[..., QK_NOPE_DIM:]
    q_rope = apply_rope(q_rope, cos[:, :, None, :], sin[:, :, None, :])
    k_rope = apply_rope(k_rope, cos, sin)
    kv = (rms_norm(c_kv, kv_norm_g) @ w_ukv).reshape(B, S, MLA_HEADS, QK_NOPE_DIM + V_HEAD_DIM)
    k_nope, v = kv[..., :QK_NOPE_DIM], kv[..., QK_NOPE_DIM:]
    o = causal_block_attention(q_nope, q_rope, k_nope, k_rope, v)
    o = rms_norm(o, out_norm_g.reshape(MLA_HEADS, V_HEAD_DIM))
    return o.reshape(B, S, MLA_WIDTH)


def hgrn2_mixer(hq, hf, hi, hgate, lb, norm_g):
    B, S, _ = hq.shape
    f32 = jnp.float32
    lbf = lb.astype(f32)
    log_f = jnp.logaddexp(jnp.log(lbf), jnp.log1p(-lbf) + jax.nn.log_sigmoid(hf.astype(f32)))
    k = -jnp.expm1(log_f)
    q = hq.astype(f32).reshape(B, S, HG_HEADS, HG_KEY_DIM) * (HG_KEY_DIM ** -0.5)
    k = k.reshape(B, S, HG_HEADS, HG_KEY_DIM)
    g = log_f.reshape(B, S, HG_HEADS, HG_KEY_DIM)
    v = hi.astype(f32).reshape(B, S, HG_HEADS, HG_VAL_DIM)
    n_chunks = S // HG_CHUNK

    def to_chunks(t):
        return t.reshape(B, n_chunks, HG_CHUNK, HG_HEADS, t.shape[-1]).transpose(1, 0, 3, 2, 4)

    tri = jnp.tril(jnp.ones((HG_CHUNK, HG_CHUNK), dtype=bool))

    def step(state, xs):
        qc, kc, vc, gc = xs
        G = jnp.cumsum(gc, axis=2)
        inter = jnp.einsum('bhtd,bhde->bhte', qc * jnp.exp(G), state)
        diff = G[:, :, :, None, :] - G[:, :, None, :, :]
        decay = jnp.exp(jnp.where(tri[:, :, None], diff, -jnp.inf))
        A = jnp.einsum('bhtd,bhsd,bhtsd->bhts', qc, kc, decay)
        o = inter + jnp.einsum('bhts,bhse->bhte', A, vc)
        G_last = G[:, :, -1:, :]
        state = (jnp.exp(G_last[:, :, 0, :])[..., None] * state
                 + jnp.einsum('bhsd,bhse->bhde', kc * jnp.exp(G_last - G), vc))
        return state, o

    s0 = jnp.zeros((B, HG_HEADS, HG_KEY_DIM, HG_VAL_DIM), f32)
    _, o = lax.scan(step, s0, (to_chunks(q), to_chunks(k), to_chunks(v), to_chunks(g)))
    o = o.transpose(1, 0, 3, 2, 4).reshape(B, S, HG_HEADS, HG_VAL_DIM)
    o = rms_norm(o, norm_g.reshape(HG_HEADS, HG_VAL_DIM)).reshape(B, S, HG_WIDTH)
    return (o * jax.nn.silu(hgate.astype(f32))).astype(hq.dtype)


def conv_glu_ffn(x, w_up, conv_w, conv_b, w_down):
    S = x.shape[1]
    gu = x @ w_up
    gate, up = gu[..., :D_FF], gu[..., D_FF:]
    gp = jnp.pad(gate, ((0, 0), (CONV_WIDTH - 1, 0), (0, 0)))
    conv = conv_b
    for tap in range(CONV_WIDTH):
        conv = conv + conv_w[tap] * gp[:, tap:tap + S]
    return (jax.nn.silu(conv) * up) @ w_down


def setup_inputs(seed: int = 0) -> dict:
    key = jax.random.key(seed)
    ks = jax.random.split(key, 18)
    f32 = jnp.float32

    def nrm(k, shape, scale):
        return jax.random.normal(k, shape, f32) * scale

    def gain(k, shape):
        return 1.0 + 0.02 * jax.random.normal(k, shape, f32)

    return {
        "x": nrm(ks[0], (BATCH, SEQ, D_MODEL), 1.0),
        "positions": jnp.broadcast_to(jnp.arange(SEQ, dtype=jnp.int32)[None, :], (BATCH, SEQ)),
        "mix_norm_g": gain(ks[1], (DEPTH, D_MODEL)),
        "w_in": nrm(ks[2], (DEPTH, D_MODEL, N_IN), D_MODEL ** -0.5),
        "q_norm_g": gain(ks[3], (DEPTH, Q_LORA_RANK)),
        "w_uq": nrm(ks[4], (DEPTH, Q_LORA_RANK, MLA_HEADS * (QK_NOPE_DIM + QK_ROPE_DIM)), Q_LORA_RANK ** -0.5),
        "kv_norm_g": gain(ks[5], (DEPTH, KV_LORA_RANK)),
        "w_ukv": nrm(ks[6], (DEPTH, KV_LORA_RANK, MLA_HEADS * (QK_NOPE_DIM + V_HEAD_DIM)), KV_LORA_RANK ** -0.5),
        "attn_out_norm_g": gain(ks[7], (DEPTH, MLA_WIDTH)),
        "lb_logits": nrm(ks[8], (DEPTH + 1, HG_FORGET_WIDTH), 0.1),
        "hg_norm_g": gain(ks[9], (DEPTH, HG_WIDTH)),
        "w_out": nrm(ks[10], (DEPTH, MIX_WIDTH, D_MODEL), MIX_WIDTH ** -0.5),
        "ffn_norm_g": gain(ks[11], (DEPTH, D_MODEL)),
        "w_up": nrm(ks[12], (DEPTH, D_MODEL, 2 * D_FF), D_MODEL ** -0.5),
        "conv_w": nrm(ks[13], (DEPTH, CONV_WIDTH, D_FF), CONV_WIDTH ** -0.5),
        "conv_b": nrm(ks[14], (DEPTH, D_FF), 0.01),
        "w_down": nrm(ks[15], (DEPTH, D_FF, D_MODEL), D_FF ** -0.5),
        "final_norm_g": gain(ks[16], (D_MODEL,)),
    }


def reference(x, positions, mix_norm_g, w_in, q_norm_g, w_uq, kv_norm_g, w_ukv,
              attn_out_norm_g, lb_logits, hg_norm_g, w_out, ffn_norm_g, w_up,
              conv_w, conv_b, w_down, final_norm_g):
    cos, sin = rope_cos_sin(positions)
    lb_table = jnp.cumsum(jax.nn.softmax(lb_logits.astype(jnp.float32), axis=0), axis=0)
    offsets = [sum(IN_SPLITS[:i + 1]) for i in range(len(IN_SPLITS) - 1)]
    h = x
    for l in range(DEPTH):
        hn = rms_norm(h, mix_norm_g[l])
        proj = hn @ w_in[l]
        c_q, c_kv, k_rope, hq, hf, hi, hgate = jnp.split(proj, offsets, axis=-1)
        mla_out = mla_mixer(c_q, c_kv, k_rope, cos, sin, q_norm_g[l], w_uq[l],
                            kv_norm_g[l], w_ukv[l], attn_out_norm_g[l])
        hg_out = hgrn2_mixer(hq, hf, hi, hgate, lb_table[l], hg_norm_g[l])
        h = h + jnp.concatenate([mla_out, hg_out], axis=-1) @ w_out[l]
        h = h + conv_glu_ffn(rms_norm(h, ffn_norm_g[l]), w_up[l], conv_w[l], conv_b[l], w_down[l])
    return rms_norm(h, final_norm_g)
```

```cpp
#include <hip/hip_runtime.h>
#include <hip/hip_cooperative_groups.h>
#include <cstdio>
#include <cstdint>
namespace cg = cooperative_groups;

#ifndef ONE_LAUNCH
#define ONE_LAUNCH 1
#endif

namespace pg8 {
#define PG8_LAS __attribute__((address_space(3)))
typedef unsigned short bf16_t;
typedef short bf16x8 __attribute__((ext_vector_type(8)));
typedef float f32x4 __attribute__((ext_vector_type(4)));
typedef unsigned u32x4 __attribute__((ext_vector_type(4)));
constexpr int BM = 256, BK = 64, HALF = 128, HTB = HALF * BK * 2, STAGE_BYTES = 8 * HTB, NXCD = 8, WGM = 8;

__host__ __device__ __forceinline__ int lds_byte(int r, int c) { const int st = (r >> 4) * 2 + (c >> 5), rr = r & 15, cc = c & 31, ob = rr * 64 + cc * 2; return st * 1024 + (ob ^ (((ob >> 9) & 1) << 5)); }
__host__ __device__ __forceinline__ void stage_rc(int b, int& R, int& C) { const int st = b / 1024, sb = b % 1024, swz = sb ^ (((sb >> 9) & 1) << 5); R = (st >> 1) * 16 + swz / 64; C = (st & 1) * 32 + (swz % 64) / 2; }
__host__ __device__ __forceinline__ int perm32(int rho) { const int n = rho >> 4, i = rho & 15; return 8 * (i >> 2) + 4 * n + (i & 3); }

struct Unit { int pm, pn; };
struct Gemm { const bf16_t* A; const bf16_t* Bt; int M, N, K, lda, ldb; };

struct StaticOrder {
    int nM, nN, nwg, G, c;
    __host__ __device__ void init(int M, int N, int G_, int c_) { nM = M / BM; nN = N / BM; nwg = nM * nN; G = G_; c = c_; }
    __host__ __device__ bool next(int i, Unit& u) const {
        const long L = (long)i * G + c; if (L >= nwg) return false;
        int wgid = (int)L; { const int q = nwg / NXCD, r = nwg % NXCD, xcd = wgid % NXCD, off = wgid / NXCD; wgid = (xcd < r ? xcd * (q + 1) : r * (q + 1) + (xcd - r) * q) + off; }
        const int nig = WGM * nN, gid = wgid / nig, fm = gid * WGM, gsz = (nM - fm) < WGM ? (nM - fm) : WGM;
        u.pm = fm + ((wgid % nig) % gsz); u.pn = (wgid % nig) / gsz; return true;
    }
};

typedef float f32x2_t __attribute__((ext_vector_type(2))); typedef __bf16 bf16x2_t __attribute__((ext_vector_type(2)));
__device__ __forceinline__ unsigned cvt_pk_bf16(float lo, float hi) { f32x2_t v = {lo, hi}; bf16x2_t b = __builtin_convertvector(v, bf16x2_t); return __builtin_bit_cast(unsigned, b); }

template <bool COLSCALE, bool SSOUT> struct EpiScaleBf16 {
    bf16_t* O; int ldc; const float* ssin; float inv_n, eps, cs; float* ssq; float* sskv;
    __device__ __forceinline__ void operator()(const f32x4 (&acc)[2][2][4][2], const Unit& u, int wr, int wc, int fr, int fq) const {
        const int row0 = u.pm * BM + wr * 64 + fr, col0 = u.pn * BM + wc * 32 + 8 * fq;
        f32x4 csv[2][2];
        if (COLSCALE) {
#pragma unroll
            for (int bj = 0; bj < 2; ++bj)
#pragma unroll
                for (int n = 0; n < 2; ++n) { const f32x4 s = *(const f32x4*)(ssin + col0 + bj * HALF + 4 * n);
#pragma unroll
                    for (int j = 0; j < 4; ++j) csv[bj][n][j] = __builtin_amdgcn_rsqf(s[j] * inv_n + eps) * cs; }
        }
#pragma unroll
        for (int ai = 0; ai < 2; ++ai)
#pragma unroll
            for (int m = 0; m < 4; ++m) {
                const int row = row0 + ai * HALF + m * 16;
                float rs = 1.f; if (!COLSCALE) rs = __builtin_amdgcn_rsqf(ssin[row] * inv_n + eps) * cs;
                float sq = 0.f;
                bf16_t* rowp = O + (size_t)row * ldc + col0;
#pragma unroll
                for (int bj = 0; bj < 2; ++bj) {
                    f32x4 v0 = acc[ai][bj][m][0], v1 = acc[ai][bj][m][1];
                    if (COLSCALE) { v0 = v0 * csv[bj][0]; v1 = v1 * csv[bj][1]; } else { v0 = v0 * rs; v1 = v1 * rs; }
                    if (SSOUT) sq += (v0[0] * v0[0] + v0[1] * v0[1]) + (v0[2] * v0[2] + v0[3] * v0[3]) + (v1[0] * v1[0] + v1[1] * v1[1]) + (v1[2] * v1[2] + v1[3] * v1[3]);
                    u32x4 w; w.x = cvt_pk_bf16(v0[0], v0[1]); w.y = cvt_pk_bf16(v0[2], v0[3]); w.z = cvt_pk_bf16(v1[0], v1[1]); w.w = cvt_pk_bf16(v1[2], v1[3]);
                    *(u32x4*)(rowp + bj * HALF) = w;
                }
                if (SSOUT) { if (u.pn < 5) { sq += __shfl_xor(sq, 16); sq += __shfl_xor(sq, 32); if (fq == 0) atomicAdd((u.pn < 3 ? ssq : sskv) + row, sq); } }
            }
    }
};
template <int MODE> struct EpiRes {
    const float* basef; const bf16_t* baseb; float* out; bf16_t* ob; int ldc; float* ss;
    __device__ __forceinline__ void operator()(const f32x4 (&acc)[2][2][4][2], const Unit& u, int wr, int wc, int fr, int fq) const {
        const int row0 = u.pm * BM + wr * 64 + fr, col0 = u.pn * BM + wc * 32 + 8 * fq;
#pragma unroll
        for (int ai = 0; ai < 2; ++ai)
#pragma unroll
            for (int m = 0; m < 4; ++m) {
                const int row = row0 + ai * HALF + m * 16; float sq = 0.f;
#pragma unroll
                for (int bj = 0; bj < 2; ++bj) {
                    const size_t p = (size_t)row * ldc + col0 + bj * HALF;
                    f32x4 b0, b1;
                    if (MODE == 0) { b0 = *(const f32x4*)(basef + p); b1 = *(const f32x4*)(basef + p + 4); }
                    else { const u32x4 w = *(const u32x4*)(baseb + p);
                        b0 = (f32x4){__builtin_bit_cast(float, w.x << 16), __builtin_bit_cast(float, w.x & 0xffff0000u), __builtin_bit_cast(float, w.y << 16), __builtin_bit_cast(float, w.y & 0xffff0000u)};
                        b1 = (f32x4){__builtin_bit_cast(float, w.z << 16), __builtin_bit_cast(float, w.z & 0xffff0000u), __builtin_bit_cast(float, w.w << 16), __builtin_bit_cast(float, w.w & 0xffff0000u)}; }
                    const f32x4 v0 = acc[ai][bj][m][0] + b0, v1 = acc[ai][bj][m][1] + b1;
                    if (MODE == 0) { u32x4 w; w.x = cvt_pk_bf16(v0[0], v0[1]); w.y = cvt_pk_bf16(v0[2], v0[3]); w.z = cvt_pk_bf16(v1[0], v1[1]); w.w = cvt_pk_bf16(v1[2], v1[3]); *(u32x4*)(ob + p) = w; }
                    else { u32x4 w; w.x = cvt_pk_bf16(v0[0], v0[1]); w.y = cvt_pk_bf16(v0[2], v0[3]); w.z = cvt_pk_bf16(v1[0], v1[1]); w.w = cvt_pk_bf16(v1[2], v1[3]); *(u32x4*)(ob + p) = w; }
                    sq += (v0[0] * v0[0] + v0[1] * v0[1]) + (v0[2] * v0[2] + v0[3] * v0[3]) + (v1[0] * v1[0] + v1[1] * v1[1]) + (v1[2] * v1[2] + v1[3] * v1[3]);
                }
                sq += __shfl_xor(sq, 16); sq += __shfl_xor(sq, 32); if (fq == 0) atomicAdd(ss + row, sq);
            }
    }
};

__device__ __forceinline__ float dpp_ror1(float v) { return __builtin_bit_cast(float, __builtin_amdgcn_mov_dpp(__builtin_bit_cast(int, v), 0x121, 0xf, 0xf, true)); }
__device__ __forceinline__ float dpp_ror2(float v) { return __builtin_bit_cast(float, __builtin_amdgcn_mov_dpp(__builtin_bit_cast(int, v), 0x122, 0xf, 0xf, true)); }
struct EpiConvGlu {
    bf16_t* act; int ldc; const float* ssin; float inv_n, eps; const float* cw; const float* cb; int dff; float* halo_g; float* fixb; PG8_LAS float* hl; int ntn;
    __device__ __forceinline__ void operator()(const f32x4 (&acc)[2][2][4][2], const Unit& u, int wr, int wc, int fr, int fq) const {
        const int cl = wc * 32 + 8 * fq, ch0 = u.pn * 128 + cl;
        float w0[8], w1[8], w2[8], bb[8];
#pragma unroll
        for (int n = 0; n < 2; ++n) { const f32x4 a = *(const f32x4*)(cw + ch0 + 4 * n), b = *(const f32x4*)(cw + dff + ch0 + 4 * n), c = *(const f32x4*)(cw + 2 * dff + ch0 + 4 * n), d = *(const f32x4*)(cb + ch0 + 4 * n);
#pragma unroll
            for (int j = 0; j < 4; ++j) { w0[4 * n + j] = a[j]; w1[4 * n + j] = b[j]; w2[4 * n + j] = c[j]; bb[4 * n + j] = d[j]; } }
        const int row0 = u.pm * BM + wr * 64 + fr;
        float rs[2][4];
#pragma unroll
        for (int ai = 0; ai < 2; ++ai)
#pragma unroll
            for (int m = 0; m < 4; ++m) rs[ai][m] = __builtin_amdgcn_rsqf(ssin[row0 + ai * HALF + m * 16] * inv_n + eps);
        if (fr >= 14) {
#pragma unroll
            for (int ai = 0; ai < 2; ++ai) {
                const f32x4 g0 = acc[ai][0][3][0] * rs[ai][3], g1 = acc[ai][0][3][1] * rs[ai][3];
                PG8_LAS float* hp = hl + ((wr * 2 + ai) * 2 + (fr - 14)) * 128 + cl;
                *(PG8_LAS f32x4*)hp = g0; *(PG8_LAS f32x4*)(hp + 4) = g1;
                if (wr == 1 && ai == 1) { float* gp = halo_g + ((size_t)(u.pm * ntn + u.pn) * 2 + (fr - 14)) * 128 + cl; *(f32x4*)gp = g0; *(f32x4*)(gp + 4) = g1; }
            }
        }
        asm volatile("s_waitcnt lgkmcnt(0)" ::: "memory"); __builtin_amdgcn_s_barrier(); asm volatile("" ::: "memory");
#pragma unroll
        for (int ai = 0; ai < 2; ++ai) {
            float prev[8];
#pragma unroll
            for (int k = 0; k < 8; ++k) prev[k] = 0.f;
            const bool tile_first = (wr == 0 && ai == 0);
            if (fr >= 14 && !tile_first) {
                const int swr = wr == 1 ? 0 : 1, sai = wr == 1 ? ai : 0;
                const PG8_LAS float* hp = hl + ((swr * 2 + sai) * 2 + (fr - 14)) * 128 + cl;
                const f32x4 h0 = *(const PG8_LAS f32x4*)hp, h1 = *(const PG8_LAS f32x4*)(hp + 4);
#pragma unroll
                for (int j = 0; j < 4; ++j) { prev[j] = h0[j]; prev[4 + j] = h1[j]; }
            }
#pragma unroll
            for (int m = 0; m < 4; ++m) {
                const int row = row0 + ai * HALF + m * 16;
                const f32x4 gv0 = acc[ai][0][m][0] * rs[ai][m], gv1 = acc[ai][0][m][1] * rs[ai][m], uv0 = acc[ai][1][m][0] * rs[ai][m], uv1 = acc[ai][1][m][1] * rs[ai][m];
                float gm[8], res[8], cv[8];
#pragma unroll
                for (int j = 0; j < 4; ++j) { gm[j] = gv0[j]; gm[4 + j] = gv1[j]; }
#pragma unroll
                for (int k = 0; k < 8; ++k) {
                    const float a1 = dpp_ror1(gm[k]), b1 = dpp_ror1(prev[k]), a2 = dpp_ror2(gm[k]), b2 = dpp_ror2(prev[k]);
                    const float p1 = fr >= 1 ? a1 : b1, p2 = fr >= 2 ? a2 : b2;
                    cv[k] = bb[k] + w0[k] * p2 + w1[k] * p1 + w2[k] * gm[k];
                    const float uu = k < 4 ? uv0[k & 3] : uv1[k & 3];
                    res[k] = cv[k] * __builtin_amdgcn_rcpf(1.f + __expf(-cv[k])) * uu;
                }
                if (tile_first && m == 0 && fr < 2) {
                    float* fp = fixb + (((size_t)(u.pm * ntn + u.pn) * 2 + fr) * 2) * 128 + cl;
                    *(f32x4*)fp = (f32x4){cv[0], cv[1], cv[2], cv[3]}; *(f32x4*)(fp + 4) = (f32x4){cv[4], cv[5], cv[6], cv[7]};
                    *(f32x4*)(fp + 128) = uv0; *(f32x4*)(fp + 132) = uv1;
                } else {
                    u32x4 w; w.x = cvt_pk_bf16(res[0], res[1]); w.y = cvt_pk_bf16(res[2], res[3]); w.z = cvt_pk_bf16(res[4], res[5]); w.w = cvt_pk_bf16(res[6], res[7]);
                    *(u32x4*)(act + (size_t)row * ldc + ch0) = w;
                }
#pragma unroll
                for (int k = 0; k < 8; ++k) prev[k] = gm[k];
            }
        }
    }
};

template <class Epi, class Sched>
__device__ __forceinline__ void gemm_phase(PG8_LAS unsigned char* lds, const Gemm g, const Sched& S, const Epi& E) {
    const int tid = threadIdx.x, wid = __builtin_amdgcn_readfirstlane(tid >> 6), lane = tid & 63, wr = wid >> 2, wc = wid & 3, fr = lane & 15, fq = lane >> 4;
    const int K = g.K, nt = K / BK;
    unsigned voffA[2], voffB[2];
#pragma unroll
    for (int i = 0; i < 2; ++i) { int R, C; stage_rc(tid * 16 + i * 8192, R, C); const int Rb = (R & ~31) + perm32(R & 31);
        voffA[i] = (unsigned)(R * g.lda + C) * 2u; voffB[i] = (unsigned)(Rb * g.ldb + C) * 2u; }
    const size_t kstep = (size_t)(BK * 2);
    const size_t hstepA = (size_t)HALF * g.lda * 2, hstepB = (size_t)HALF * g.ldb * 2;
    const size_t tstepA = 2 * hstepA, tstepB = 2 * hstepB;
    const unsigned ldsw = (unsigned)wid * 1024u;
    const int aoff = lds_byte(wr * 64 + fr, fq * 8), boff = lds_byte(wc * 32 + fr, fq * 8);
#define PG8_SA(b, h) (((b) * 2 + (h)) * HTB)
#define PG8_SB(b, h) ((4 + (b) * 2 + (h)) * HTB)
#define PG8_STAGE(bufoff, gbase, voff) do { _Pragma("unroll") for (int _i = 0; _i < 2; ++_i) \
        __builtin_amdgcn_global_load_lds((const unsigned*)((const char*)(gbase) + (voff)[_i]), (PG8_LAS unsigned*)(lds + (bufoff) + ldsw + _i * 8192), 16, 0, 0); } while (0)
#define PG8_LDA(dst, b, h) do { _Pragma("unroll") for (int m = 0; m < 4; ++m) _Pragma("unroll") for (int k = 0; k < 2; ++k) dst[m][k] = *(const PG8_LAS bf16x8*)(lds + PG8_SA(b, h) + aoff + m * 2048 + k * 1024); } while (0)
#define PG8_LDB(dst, b, h) do { _Pragma("unroll") for (int n = 0; n < 2; ++n) _Pragma("unroll") for (int k = 0; k < 2; ++k) dst[n][k] = *(const PG8_LAS bf16x8*)(lds + PG8_SB(b, h) + boff + n * 2048 + k * 1024); } while (0)
#define PG8_MMA(ai, bj, At, Bt) do { __builtin_amdgcn_s_setprio(1); _Pragma("unroll") for (int m = 0; m < 4; ++m) _Pragma("unroll") for (int n = 0; n < 2; ++n) _Pragma("unroll") for (int k = 0; k < 2; ++k) \
        acc[ai][bj][m][n] = __builtin_amdgcn_mfma_f32_16x16x32_bf16(Bt[n][k], At[m][k], acc[ai][bj][m][n], 0, 0, 0); __builtin_amdgcn_s_setprio(0); } while (0)
#define PG8_WAIT_V(n) asm volatile("s_waitcnt vmcnt(" #n ")" ::: "memory")
#define PG8_WAIT_L(n) asm volatile("s_waitcnt lgkmcnt(" #n ")" ::: "memory")
#define PG8_BAR __builtin_amdgcn_s_barrier()
#define PG8_SCHED __builtin_amdgcn_sched_barrier(0)
    Unit cur, nxt; int ui = 0;
    if (!S.next(0, cur)) return;
    f32x4 acc[2][2][4][2];
#pragma unroll
    for (int a = 0; a < 2; ++a)
#pragma unroll
        for (int b = 0; b < 2; ++b)
#pragma unroll
            for (int m = 0; m < 4; ++m)
#pragma unroll
                for (int n = 0; n < 2; ++n) acc[a][b][m][n] = (f32x4){0.f, 0.f, 0.f, 0.f};
    bf16x8 At[4][2], B0[2][2], B1[2][2];
    const char* cA = (const char*)g.A + (size_t)cur.pm * tstepA; const char* cB = (const char*)g.Bt + (size_t)cur.pn * tstepB;
    PG8_STAGE(PG8_SB(0, 0), cB, voffB); PG8_STAGE(PG8_SB(0, 1), cB + hstepB, voffB); PG8_STAGE(PG8_SA(0, 0), cA, voffA); PG8_STAGE(PG8_SA(0, 1), cA + hstepA, voffA);
    if (wr == 1) PG8_BAR;
    PG8_WAIT_V(2); PG8_BAR;
    PG8_STAGE(PG8_SB(1, 0), cB + kstep, voffB); PG8_STAGE(PG8_SA(1, 0), cA + kstep, voffA); PG8_STAGE(PG8_SB(1, 1), cB + hstepB + kstep, voffB);
    PG8_WAIT_V(6); PG8_BAR;
    for (;;) {
        const bool has_next = S.next(ui + 1, nxt);
        const char* nA = has_next ? (const char*)g.A + (size_t)nxt.pm * tstepA : cA; const char* nB = has_next ? (const char*)g.Bt + (size_t)nxt.pn * tstepB : cB;
        for (int t = 0; t < nt; t += 2) {
            const bool last = (t == nt - 2);
            const char* a1 = cA + (size_t)(t + 1) * kstep;
            const char* a2 = last ? nA : cA + (size_t)(t + 2) * kstep; const char* b2 = last ? nB : cB + (size_t)(t + 2) * kstep;
            const char* a3 = a2 + kstep; const char* b3 = b2 + kstep;
            PG8_LDB(B0, 0, 0); PG8_LDB(B1, 0, 1); PG8_SCHED; PG8_LDA(At, 0, 0); PG8_STAGE(PG8_SA(1, 1), a1 + hstepA, voffA);
            PG8_WAIT_V(8); PG8_WAIT_L(0); PG8_BAR; PG8_MMA(0, 0, At, B0); PG8_MMA(0, 1, At, B1); PG8_BAR; PG8_SCHED;
            PG8_LDA(At, 0, 1); PG8_STAGE(PG8_SB(0, 0), b2, voffB); PG8_STAGE(PG8_SB(0, 1), b2 + hstepB, voffB); PG8_STAGE(PG8_SA(0, 0), a2, voffA);
            PG8_WAIT_V(8); PG8_WAIT_L(0); PG8_BAR; PG8_MMA(1, 0, At, B0); PG8_MMA(1, 1, At, B1); PG8_BAR; PG8_SCHED;
            PG8_LDB(B0, 1, 0); PG8_LDB(B1, 1, 1); PG8_SCHED; PG8_LDA(At, 1, 0); PG8_STAGE(PG8_SA(0, 1), a2 + hstepA, voffA);
            PG8_WAIT_V(8); PG8_WAIT_L(0); PG8_BAR; PG8_MMA(0, 0, At, B0); PG8_MMA(0, 1, At, B1); PG8_BAR; PG8_SCHED;
            PG8_LDA(At, 1, 1); PG8_STAGE(PG8_SB(1, 0), b3, voffB); PG8_STAGE(PG8_SB(1, 1), b3 + hstepB, voffB); PG8_STAGE(PG8_SA(1, 0), a3, voffA);
            PG8_WAIT_V(8); PG8_WAIT_L(0); PG8_BAR; PG8_MMA(1, 0, At, B0); PG8_MMA(1, 1, At, B1); PG8_BAR; PG8_SCHED;
        }
        if (wr == 0) PG8_BAR;
        E(acc, cur, wr, wc, fr, fq);
        if (!has_next) break;
#pragma unroll
        for (int a = 0; a < 2; ++a)
#pragma unroll
            for (int b = 0; b < 2; ++b)
#pragma unroll
                for (int m = 0; m < 4; ++m)
#pragma unroll
                    for (int n = 0; n < 2; ++n) acc[a][b][m][n] = (f32x4){0.f, 0.f, 0.f, 0.f};
        cur = nxt; cA = nA; cB = nB; ++ui;
        if (wr == 1) PG8_BAR;
    }
    PG8_WAIT_V(0);
    PG8_BAR;
#undef PG8_SA
#undef PG8_SB
#undef PG8_STAGE
#undef PG8_LDA
#undef PG8_LDB
#undef PG8_MMA
#undef PG8_WAIT_V
#undef PG8_WAIT_L
#undef PG8_BAR
#undef PG8_SCHED
}
}

typedef unsigned short bf16;
typedef short bf16x8 __attribute__((ext_vector_type(8)));
typedef float f32x4 __attribute__((ext_vector_type(4)));
typedef float f32x16 __attribute__((ext_vector_type(16)));
typedef unsigned u32x4 __attribute__((ext_vector_type(4)));
typedef unsigned u32x2 __attribute__((ext_vector_type(2)));
#define LAS __attribute__((address_space(3)))

constexpr int BATCH = 2, SEQ = 8192, T = BATCH * SEQ, DM = 4096;
constexpr int NINP = 9728;
constexpr int PC_CQ = 0, PC_CKV = 768, PC_KR = 1280, PC_HQ = 1536, PC_HF = 3584, PC_HI = 5632, PC_HG = 7680;
constexpr int NQ = 3072, NKN = 2048, DFF = 11008, NUP = 2 * DFF;
constexpr float EPS = 1e-6f;
constexpr float C2 = 0.07216878364870322f * 1.4426950408889634f;
constexpr int NWAVES = 8, NTHR = 512;

constexpr size_t WS_CTL = 0;
constexpr size_t WS_WDOWN = 1u << 20;
constexpr size_t WS_WOUT = WS_WDOWN + (size_t)DM * DFF * 2;
constexpr size_t WS_WIN = WS_WOUT + (size_t)DM * DM * 2;
constexpr size_t WS_WUQ = WS_WIN + (size_t)NINP * DM * 2;
constexpr size_t WS_WKV = WS_WUQ + (size_t)NQ * 768 * 2;
constexpr size_t WS_WUP = WS_WKV + (size_t)4096 * 512 * 2;
constexpr size_t WS_H1B = WS_WUP + (size_t)NUP * DM * 2;
constexpr size_t WS_R = WS_H1B + (size_t)T * DM * 2;
constexpr size_t WS_XB = WS_R;
constexpr size_t WS_PROJ = WS_XB + (size_t)T * DM * 2;
constexpr size_t WS_Q = WS_PROJ + (size_t)T * NINP * 2;
constexpr size_t WS_KN = WS_Q + (size_t)T * NQ * 2;
constexpr size_t WS_VT = WS_KN + (size_t)T * NKN * 2;
constexpr size_t WS_KR = WS_VT + (size_t)T * 2048 * 2;
constexpr size_t WS_MIX = WS_KR + (size_t)T * 64 * 2;
constexpr size_t WS_END = WS_MIX + (size_t)T * DM * 2;
constexpr size_t WS_ACT = WS_R;
constexpr size_t WS_HALO = WS_ACT + (size_t)T * DFF * 2;
constexpr size_t WS_FIX = WS_HALO + (size_t)64 * 86 * 2 * 128 * 4;
constexpr size_t WS_H2B = WS_FIX + (size_t)64 * 86 * 4 * 128 * 4;
static_assert(WS_H2B + (size_t)T * DM * 2 <= WS_END, "act/halo/fix/h2b overlay");
constexpr int CF_SS1 = 0, CF_SSQ = 16384, CF_SSKV = 32768, CF_SS2 = 49152, CF_SS3 = 65536, CF_QCNT = 81920, CF_LBV = 82944, CF_ZERO_BEGIN = CF_SSQ, CF_ZERO_END = CF_QCNT + 64;

constexpr int LDS_BYTES = 143360;

__device__ const float INV_FREQ[32] = {1.000000000e+00f, 7.498942018e-01f, 5.623413324e-01f, 4.216965139e-01f, 3.162277639e-01f, 2.371373922e-01f, 1.778279394e-01f, 1.333521456e-01f, 1.000000015e-01f, 7.498941571e-02f, 5.623412877e-02f, 4.216964915e-02f, 3.162277862e-02f, 2.371373586e-02f, 1.778279431e-02f, 1.333521493e-02f, 9.999999776e-03f, 7.498942316e-03f, 5.623413250e-03f, 4.216964822e-03f, 3.162277862e-03f, 2.371373819e-03f, 1.778279431e-03f, 1.333521446e-03f, 1.000000047e-03f, 7.498941850e-04f, 5.623413017e-04f, 4.216965463e-04f, 3.162277862e-04f, 2.371373848e-04f, 1.778279402e-04f, 1.333521504e-04f};

struct Params {
    const float* x; const int* pos; const float* mix_g; const float* w_in; const float* qn_g; const float* w_uq; const float* kvn_g; const float* w_ukv;
    const float* attn_g; const float* lb; const float* hg_g; const float* w_out; const float* ffn_g; const float* w_up; const float* conv_w; const float* conv_b;
    const float* w_down; const float* fin_g; float* out; unsigned char* ws; int ph_lo, ph_hi;
};

__device__ __forceinline__ unsigned f2bf(float f) { unsigned u = __builtin_bit_cast(unsigned, f); return (u + 0x7fffu + ((u >> 16) & 1u)) >> 16; }
__device__ __forceinline__ unsigned pk2(float lo, float hi) { return pg8::cvt_pk_bf16(lo, hi); }
__device__ __forceinline__ float bf2f(unsigned short b) { return __builtin_bit_cast(float, (unsigned)b << 16); }
__device__ __forceinline__ float wave_sum(float v) {
#pragma unroll
    for (int o = 1; o < 64; o <<= 1) v += __shfl_xor(v, o);
    return v;
}
__device__ __forceinline__ void sincos_big(float ang, float& c, float& s) {
    const double rev = (double)ang * 0.15915494309189535; const float fr = (float)(rev - __builtin_floor(rev));
    s = __builtin_amdgcn_sinf(fr); c = __builtin_amdgcn_cosf(fr);
}

__device__ __forceinline__ void transpose_item(const float* W, int ldw, int src_col0, const float* gain, bf16* WT, int K, int dst_row0, int k0, LAS float* scr, int lane) {
    if (src_col0 >= 0) {
        float wv[32];
        const float* wp = W + (size_t)(k0 + (lane >> 5)) * ldw + src_col0 + (lane & 31);
#pragma unroll
        for (int i = 0; i < 32; ++i) wv[i] = __builtin_nontemporal_load(wp + (size_t)(2 * i) * ldw);
        if (gain) { const float* gp = gain + k0 + (lane >> 5);
#pragma unroll
            for (int i = 0; i < 32; ++i) wv[i] *= gp[2 * i]; }
#pragma unroll
        for (int i = 0; i < 32; ++i) scr[(2 * i + (lane >> 5)) * 33 + (lane & 31)] = wv[i];
    } else {
#pragma unroll 8
        for (int i = 0; i < 32; ++i) { const int kk = 2 * i + (lane >> 5); scr[kk * 33 + (lane & 31)] = 0.f; }
    }
    asm volatile("s_waitcnt lgkmcnt(0)" ::: "memory");
    const int c = lane & 7;
#pragma unroll
    for (int j = 0; j < 4; ++j) { const int n = (lane >> 3) + 8 * j; const LAS float* s = scr + (8 * c) * 33 + n;
        u32x4 o; o.x = pk2(s[0 * 33], s[1 * 33]); o.y = pk2(s[2 * 33], s[3 * 33]); o.z = pk2(s[4 * 33], s[5 * 33]); o.w = pk2(s[6 * 33], s[7 * 33]);
        *(u32x4*)(WT + (size_t)(dst_row0 + n) * K + k0 + 8 * c) = o; }
    asm volatile("s_waitcnt lgkmcnt(0)" ::: "memory");
}

constexpr int NB_IN = NINP / 32, KB_IN = DM / 64, I_IN = NB_IN * KB_IN;
constexpr int NB_UQ = NQ / 32, KB_UQ = 768 / 64, I_UQ = NB_UQ * KB_UQ;
constexpr int NB_KV = 4096 / 32, KB_KV = 512 / 64, I_KV = NB_KV * KB_KV;
constexpr int NB_OUT = DM / 32, KB_OUT = DM / 64, I_OUT = NB_OUT * KB_OUT;
constexpr int NB_UP = NUP / 32, KB_UP = DM / 64, I_UP = NB_UP * KB_UP;
constexpr int NB_DN = DM / 32, KB_DN = DFF / 64, I_DN = NB_DN * KB_DN;
constexpr int IT_EARLY = I_IN + I_UQ + I_KV;
constexpr int IT_MID = IT_EARLY + I_OUT + I_UP;
constexpr int IT_ALL = IT_MID + I_DN;
__device__ __forceinline__ void transpose_items(const Params& p, LAS unsigned char* lds, int it0, int it1, int rw, int nw) {
    const int lane = threadIdx.x & 63, wave = threadIdx.x >> 6;
    unsigned char* ws = p.ws;
    LAS float* scr = (LAS float*)(lds + wave * 16384);
    for (int it = it0 + rw; it < it1; it += nw) {
        int r = it;
        if (r < I_IN) { const int kb = r / NB_IN, nb = r % NB_IN; const int n = nb * 32; const int src = n < 1344 ? n : (n < 1536 ? -1 : n - 192);
            transpose_item(p.w_in, 9536, src, p.mix_g, (bf16*)(ws + WS_WIN), DM, n, kb * 64, scr, lane); continue; } r -= I_IN;
        if (r < I_UQ) { const int kb = r / NB_UQ, nb = r % NB_UQ; transpose_item(p.w_uq, NQ, nb * 32, p.qn_g, (bf16*)(ws + WS_WUQ), 768, nb * 32, kb * 64, scr, lane); continue; } r -= I_UQ;
        if (r < I_KV) { const int kb = r / NB_KV, nb = r % NB_KV; const int src = nb < 64 ? (nb >> 2) * 256 + (nb & 3) * 32 : ((nb - 64) >> 2) * 256 + 128 + ((nb - 64) & 3) * 32;
            transpose_item(p.w_ukv, 4096, src, p.kvn_g, (bf16*)(ws + WS_WKV), 512, nb * 32, kb * 64, scr, lane); continue; } r -= I_KV;
        if (r < I_OUT) { const int kb = r / NB_OUT, nb = r % NB_OUT; transpose_item(p.w_out, DM, nb * 32, nullptr, (bf16*)(ws + WS_WOUT), DM, nb * 32, kb * 64, scr, lane); continue; } r -= I_OUT;
        if (r < I_UP) { const int kb = r / NB_UP, nb = r % NB_UP; const int pn = nb >> 3, c0 = (nb & 7) * 32; const int src = c0 < 128 ? 128 * pn + c0 : DFF + 128 * pn + c0 - 128;
            transpose_item(p.w_up, NUP, src, p.ffn_g, (bf16*)(ws + WS_WUP), DM, nb * 32, kb * 64, scr, lane); continue; } r -= I_UP;
        { const int kb = r / NB_DN, nb = r % NB_DN; transpose_item(p.w_down, DM, nb * 32, nullptr, (bf16*)(ws + WS_WDOWN), DFF, nb * 32, kb * 64, scr, lane); }
    }
}
__device__ __forceinline__ void transpose_in_idle_round(const Params& p, LAS unsigned char* lds, int it0, int it1, int nwg, int G) {
    const int first_idle = nwg % G, c = (int)blockIdx.x, wave = threadIdx.x >> 6;
    if (first_idle == 0) transpose_items(p, lds, it0, it1, c * NWAVES + wave, G * NWAVES);
    else if (c >= first_idle) transpose_items(p, lds, it0, it1, (c - first_idle) * NWAVES + wave, (G - first_idle) * NWAVES);
}
__device__ __forceinline__ void p0_prologue(const Params& p, LAS unsigned char* lds, int G) {
    const int tid = threadIdx.x, lane = tid & 63, wave = tid >> 6;
    unsigned char* ws = p.ws; float* ctl = (float*)(ws + WS_CTL);
    const int gt = blockIdx.x * NTHR + tid, NGT = G * NTHR;
    for (int i = CF_ZERO_BEGIN + gt; i < CF_ZERO_END; i += NGT) ctl[i] = 0.f;
    for (int j = gt; j < 2048; j += NGT) ctl[CF_LBV + j] = 1.f / (1.f + __expf(p.lb[2048 + j] - p.lb[j]));
    const int gw = blockIdx.x * NWAVES + wave, NGW = G * NWAVES;
    transpose_items(p, lds, 0, IT_EARLY, gw, NGW);
    bf16* xb = (bf16*)(ws + WS_XB);
    for (int m = gw; m < T; m += NGW) {
        const f32x4* xr = (const f32x4*)(p.x + (size_t)m * DM) + lane; u32x2* o8 = (u32x2*)(xb + (size_t)m * DM) + lane; float s = 0.f;
        f32x4 xv[16];
#pragma unroll
        for (int j = 0; j < 16; ++j) xv[j] = __builtin_nontemporal_load(xr + 64 * j);
#pragma unroll
        for (int j = 0; j < 16; ++j) { const f32x4 v = xv[j]; s += (v[0] * v[0] + v[1] * v[1]) + (v[2] * v[2] + v[3] * v[3]); u32x2 w; w.x = pk2(v[0], v[1]); w.y = pk2(v[2], v[3]); o8[64 * j] = w; }
        s = wave_sum(s); if (lane == 0) ctl[CF_SS1 + m] = s;
    }
}

__device__ __forceinline__ void krope_pass(const Params& p, int G) {
    const bf16* proj = (const bf16*)(p.ws + WS_PROJ); bf16* kr = (bf16*)(p.ws + WS_KR);
    const int gt = blockIdx.x * NTHR + threadIdx.x, NGT = G * NTHR;
    for (int w = gt; w < T * 32; w += NGT) {
        const int m = w >> 5, i = w & 31;
        const float x1 = bf2f(proj[(size_t)m * NINP + PC_KR + i]), x2 = bf2f(proj[(size_t)m * NINP + PC_KR + 32 + i]);
        float c, s; sincos_big((float)p.pos[m] * INV_FREQ[i], c, s);
        kr[(size_t)m * 64 + i] = (bf16)f2bf(x1 * c - x2 * s); kr[(size_t)m * 64 + 32 + i] = (bf16)f2bf(x2 * c + x1 * s);
    }
}

constexpr int AK_STRIDE = 400, AV_STRIDE = 144, AK_BYTES = 64 * AK_STRIDE, AV_BYTES = 128 * AV_STRIDE;
constexpr int A_KOFF = 0, A_VOFF = 2 * AK_BYTES, ATTN_LDS = 2 * AK_BYTES + 2 * AV_BYTES;
__device__ __forceinline__ int kperm(int r) { return (r & ~12) | ((r & 4) << 1) | ((r & 8) >> 1); }

__device__ __forceinline__ void attn_unit(const Params& p, int b, int h, int qb, unsigned char* lds) {
    const int tid = threadIdx.x, lane = tid & 63, r32 = lane & 31, hi = lane >> 5, wid = __builtin_amdgcn_readfirstlane(tid >> 6);
    const bf16* qg = (const bf16*)(p.ws + WS_Q); const bf16* kn = (const bf16*)(p.ws + WS_KN); const bf16* kr = (const bf16*)(p.ws + WS_KR); const bf16* vt = (const bf16*)(p.ws + WS_VT);
    bf16* mix = (bf16*)(p.ws + WS_MIX);
    const int rowbase = b * SEQ, q0 = qb * 256;
    const int qrow = rowbase + q0 + wid * 32 + r32, qpos = q0 + wid * 32 + r32;
    const bf16* ksrc[3]; int kdst[3]; size_t kstep[3];
#pragma unroll
    for (int i = 0; i < 3; ++i) { const int pc = tid + 512 * i, rho = pc / 24, c = pc % 24, key = (rho & ~31) + kperm(rho & 31);
        if (c < 16) { ksrc[i] = kn + (size_t)(rowbase + key) * NKN + h * 128 + c * 8; kstep[i] = (size_t)64 * NKN; }
        else { ksrc[i] = kr + (size_t)(rowbase + key) * 64 + (c - 16) * 8; kstep[i] = (size_t)64 * 64; }
        kdst[i] = rho * AK_STRIDE + c * 16; }
    const bf16* vsrc[2]; int vdst[2];
#pragma unroll
    for (int i = 0; i < 2; ++i) { const int pc = tid + 512 * i, d = pc >> 3, c = pc & 7; vsrc[i] = vt + (size_t)(h * 128 + d) * T + rowbase + c * 8; vdst[i] = d * AV_STRIDE + c * 16; }
    const int NT = (q0 + 256) / 64;
    u32x4 kreg[3], vreg[2];
#pragma unroll
    for (int i = 0; i < 3; ++i) kreg[i] = *(const u32x4*)(ksrc[i]);
#pragma unroll
    for (int i = 0; i < 2; ++i) vreg[i] = *(const u32x4*)(vsrc[i]);
    bf16x8 qf[12];
    { const bf16* qp = qg + (size_t)qrow * NQ + h * 192 + 8 * hi;
#pragma unroll
      for (int d0 = 0; d0 < 12; ++d0) qf[d0] = *(const bf16x8*)(qp + 16 * d0);
      const float fpos = (float)p.pos[qrow];
#pragma unroll
      for (int jj = 0; jj < 2; ++jj)
#pragma unroll
          for (int j = 0; j < 8; ++j) { const int i = 16 * jj + 8 * hi + j; float c, s; sincos_big(fpos * INV_FREQ[i], c, s);
              const float x1 = bf2f((unsigned short)qf[8 + jj][j]), x2 = bf2f((unsigned short)qf[10 + jj][j]);
              qf[8 + jj][j] = (short)f2bf(x1 * c - x2 * s); qf[10 + jj][j] = (short)f2bf(x2 * c + x1 * s); }
    }
#pragma unroll
    for (int i = 0; i < 3; ++i) *(u32x4*)(lds + A_KOFF + kdst[i]) = kreg[i];
#pragma unroll
    for (int i = 0; i < 2; ++i) *(u32x4*)(lds + A_VOFF + vdst[i]) = vreg[i];
    __syncthreads();
    f32x16 o[4];
#pragma unroll
    for (int d = 0; d < 4; ++d)
#pragma unroll
        for (int r = 0; r < 16; ++r) o[d][r] = 0.f;
    float m_run = 0.f, l_run = 0.f;
    const int wave_last = q0 + wid * 32 + 31;
    for (int t = 0; t < NT; ++t) {
        const int kv0 = 64 * t, buf = t & 1;
        if (t + 1 < NT) {
#pragma unroll
            for (int i = 0; i < 3; ++i) kreg[i] = *(const u32x4*)(ksrc[i] + (size_t)(t + 1) * kstep[i]);
#pragma unroll
            for (int i = 0; i < 2; ++i) vreg[i] = *(const u32x4*)(vsrc[i] + (size_t)(t + 1) * 64);
        }
        if (kv0 <= wave_last) {
            const unsigned char* Kb = lds + A_KOFF + buf * AK_BYTES + r32 * AK_STRIDE + hi * 16;
            const unsigned char* Vb = lds + A_VOFF + buf * AV_BYTES + r32 * AV_STRIDE + hi * 16;
            f32x16 s0, s1;
#pragma unroll
            for (int r = 0; r < 16; ++r) { s0[r] = -m_run; s1[r] = -m_run; }
            const unsigned char* Kb1 = Kb + 32 * AK_STRIDE;
            bf16x8 ka0 = *(const bf16x8*)(Kb), kb0 = *(const bf16x8*)(Kb1), ka1 = *(const bf16x8*)(Kb + 32), kb1 = *(const bf16x8*)(Kb1 + 32), ka2 = *(const bf16x8*)(Kb + 64), kb2 = *(const bf16x8*)(Kb1 + 64);
            __builtin_amdgcn_s_setprio(1);
#pragma unroll
            for (int d0 = 0; d0 < 12; d0 += 3) {
                s0 = __builtin_amdgcn_mfma_f32_32x32x16_bf16(ka0, qf[d0], s0, 0, 0, 0);
                s1 = __builtin_amdgcn_mfma_f32_32x32x16_bf16(kb0, qf[d0], s1, 0, 0, 0);
                if (d0 + 3 < 12) { ka0 = *(const bf16x8*)(Kb + (d0 + 3) * 32); kb0 = *(const bf16x8*)(Kb1 + (d0 + 3) * 32); }
                __builtin_amdgcn_sched_barrier(0);
                s0 = __builtin_amdgcn_mfma_f32_32x32x16_bf16(ka1, qf[d0 + 1], s0, 0, 0, 0);
                s1 = __builtin_amdgcn_mfma_f32_32x32x16_bf16(kb1, qf[d0 + 1], s1, 0, 0, 0);
                if (d0 + 4 < 12) { ka1 = *(const bf16x8*)(Kb + (d0 + 4) * 32); kb1 = *(const bf16x8*)(Kb1 + (d0 + 4) * 32); }
                __builtin_amdgcn_sched_barrier(0);
                s0 = __builtin_amdgcn_mfma_f32_32x32x16_bf16(ka2, qf[d0 + 2], s0, 0, 0, 0);
                s1 = __builtin_amdgcn_mfma_f32_32x32x16_bf16(kb2, qf[d0 + 2], s1, 0, 0, 0);
                if (d0 + 5 < 12) { ka2 = *(const bf16x8*)(Kb + (d0 + 5) * 32); kb2 = *(const bf16x8*)(Kb1 + (d0 + 5) * 32); }
                __builtin_amdgcn_sched_barrier(0);
            }
            __builtin_amdgcn_s_setprio(0);
            if (kv0 + 63 > q0 + wid * 32) {
#pragma unroll
                for (int r = 0; r < 16; ++r) { const int key = kv0 + 16 * (r >> 3) + 8 * hi + (r & 7);
                    if (key > qpos) s0[r] = -INFINITY; if (key + 32 > qpos) s1[r] = -INFINITY; }
            }
            float mx = fmaxf(s0[0], s1[0]);
#pragma unroll
            for (int r = 1; r < 16; ++r) mx = fmaxf(mx, fmaxf(s0[r], s1[r]));
            mx = fmaxf(mx, __shfl_xor(mx, 32));
            if (__any(mx > 8.f)) {
                const float dl = fmaxf(mx, 0.f), alpha = __builtin_amdgcn_exp2f(-dl); m_run += dl;
                l_run *= alpha;
#pragma unroll
                for (int r = 0; r < 16; ++r) { s0[r] -= dl; s1[r] -= dl; }
#pragma unroll
                for (int d = 0; d < 4; ++d)
#pragma unroll
                    for (int r = 0; r < 16; ++r) o[d][r] *= alpha;
            }
            float sum = 0.f;
#pragma unroll
            for (int r = 0; r < 16; ++r) { s0[r] = __builtin_amdgcn_exp2f(s0[r]); s1[r] = __builtin_amdgcn_exp2f(s1[r]); sum += s0[r] + s1[r]; }
            l_run += sum;
            bf16x8 pb[2][2];
#pragma unroll
            for (int ks = 0; ks < 2; ++ks) {
                u32x4 w0, w1;
                w0.x = pk2(s0[8 * ks + 0], s0[8 * ks + 1]); w0.y = pk2(s0[8 * ks + 2], s0[8 * ks + 3]); w0.z = pk2(s0[8 * ks + 4], s0[8 * ks + 5]); w0.w = pk2(s0[8 * ks + 6], s0[8 * ks + 7]);
                w1.x = pk2(s1[8 * ks + 0], s1[8 * ks + 1]); w1.y = pk2(s1[8 * ks + 2], s1[8 * ks + 3]); w1.z = pk2(s1[8 * ks + 4], s1[8 * ks + 5]); w1.w = pk2(s1[8 * ks + 6], s1[8 * ks + 7]);
                pb[0][ks] = __builtin_bit_cast(bf16x8, w0); pb[1][ks] = __builtin_bit_cast(bf16x8, w1);
            }
            bf16x8 va[4];
#pragma unroll
            for (int i = 0; i < 4; ++i) va[i] = *(const bf16x8*)(Vb + (i >> 2) * 32 * AV_STRIDE + (i & 3) * 32);
            __builtin_amdgcn_s_setprio(1);
#pragma unroll
            for (int i = 0; i < 16; ++i) {
                o[i >> 2] = __builtin_amdgcn_mfma_f32_32x32x16_bf16(va[i & 3], pb[(i >> 1) & 1][i & 1], o[i >> 2], 0, 0, 0);
                if (i + 4 < 16) va[i & 3] = *(const bf16x8*)(Vb + ((i + 4) >> 2) * 32 * AV_STRIDE + ((i + 4) & 3) * 32);
                __builtin_amdgcn_sched_barrier(0);
            }
            __builtin_amdgcn_s_setprio(0);
        }
        if (t + 1 < NT) {
            const int nb = buf ^ 1;
#pragma unroll
            for (int i = 0; i < 3; ++i) *(u32x4*)(lds + A_KOFF + nb * AK_BYTES + kdst[i]) = kreg[i];
#pragma unroll
            for (int i = 0; i < 2; ++i) *(u32x4*)(lds + A_VOFF + nb * AV_BYTES + vdst[i]) = vreg[i];
        }
        __syncthreads();
    }
    const float l_tot = l_run + __shfl_xor(l_run, 32), il = 1.f / l_tot;
    float ss = 0.f;
#pragma unroll
    for (int d = 0; d < 4; ++d)
#pragma unroll
        for (int r = 0; r < 16; ++r) { o[d][r] *= il; ss += o[d][r] * o[d][r]; }
    ss += __shfl_xor(ss, 32);
    const float rstd = __builtin_amdgcn_rsqf(ss * (1.f / 128.f) + EPS);
    bf16* op = mix + (size_t)qrow * DM + h * 128;
    const float* gp = p.attn_g + h * 128;
#pragma unroll
    for (int d = 0; d < 4; ++d)
#pragma unroll
        for (int g4 = 0; g4 < 4; ++g4) { const int dd = d * 32 + 8 * g4 + 4 * hi; const f32x4 gv = *(const f32x4*)(gp + dd);
            u32x2 w; w.x = pk2(o[d][4 * g4 + 0] * rstd * gv[0], o[d][4 * g4 + 1] * rstd * gv[1]); w.y = pk2(o[d][4 * g4 + 2] * rstd * gv[2], o[d][4 * g4 + 3] * rstd * gv[3]);
            *(u32x2*)(op + dd) = w; }
}

constexpr int H_QS = 136 * 2, H_TS = 72 * 2, H_OS = 132 * 4;
constexpr int H_QT = 0, H_KH = H_QT + 64 * H_QS, H_KB = H_KH + 64 * H_QS, H_VT = H_KB + 128 * H_TS, H_A = H_VT + 128 * H_TS, H_ST = H_A + 64 * H_TS,
              H_SEG = H_ST + 128 * H_QS, H_DEC = H_SEG + 4 * 128 * 4, H_END = H_DEC + 128 * 4, H_O = H_QT;
static_assert(64 * H_OS <= 2 * 64 * H_QS, "o overlay");
static_assert(H_END <= LDS_BYTES, "hgrn lds");

__device__ __forceinline__ void hgrn_stream(const Params& p, int b, int h, unsigned char* lds) {
    const int tid = threadIdx.x, lane = tid & 63, r32 = lane & 31, hi = lane >> 5, wid = __builtin_amdgcn_readfirstlane(tid >> 6);
    const bf16* proj = (const bf16*)(p.ws + WS_PROJ); bf16* mix = (bf16*)(p.ws + WS_MIX);
    const float* ctl = (const float*)(p.ws + WS_CTL);
    const int c = tid & 127, seg = tid >> 7;
    const float lbv = ctl[CF_LBV + h * 128 + c], oml = 1.f - lbv;
    const int db = wid >> 1, eb0 = 2 * (wid & 1);
    f32x16 S0, S1;
#pragma unroll
    for (int r = 0; r < 16; ++r) { S0[r] = 0.f; S1[r] = 0.f; }
    for (int i = tid; i < 128 * H_QS / 4; i += NTHR) ((unsigned*)(lds + H_ST))[i] = 0u;
    const int tb = wid >> 2, eb = wid & 3;
    __syncthreads();
    unsigned short zr[16], qr[16], vr[16];
    { const bf16* pf = proj + ((size_t)b * SEQ + 16 * seg) * NINP + h * 128 + c;
#pragma unroll
      for (int i = 0; i < 16; ++i) { zr[i] = pf[(size_t)i * NINP + PC_HF]; qr[i] = pf[(size_t)i * NINP + PC_HQ]; vr[i] = pf[(size_t)i * NINP + PC_HI]; } }
    for (int ch = 0; ch < SEQ / 64; ++ch) {
        const size_t row0 = (size_t)b * SEQ + (size_t)ch * 64;
        float G[16], kk[16];
        float run = 0.f;
#pragma unroll
        for (int i = 0; i < 16; ++i) { const float z = bf2f(zr[i]); const float ez = __expf(-z); const float sig = __builtin_amdgcn_rcpf(1.f + ez);
            const float f = lbv + oml * sig; run += __builtin_amdgcn_logf(f) * 0.6931471805599453f; G[i] = run; kk[i] = oml * ez * sig; }
        ((float*)(lds + H_SEG))[seg * 128 + c] = run;
        float qv[16], vv[16];
#pragma unroll
        for (int i = 0; i < 16; ++i) { qv[i] = bf2f(qr[i]); vv[i] = bf2f(vr[i]); }
        __syncthreads();
        float pre = 0.f, tot = 0.f;
#pragma unroll
        for (int s = 0; s < 4; ++s) { const float v = ((const float*)(lds + H_SEG))[s * 128 + c]; tot += v; if (s < seg) pre += v; }
        if (seg == 0) ((float*)(lds + H_DEC))[c] = __expf(tot);
        unsigned kbw[8], vtw[8];
#pragma unroll
        for (int i = 0; i < 16; i += 2) {
            const float g0 = G[i] + pre, g1 = G[i + 1] + pre;
            const float e0 = __expf(g0), e1 = __expf(g1);
            const int t0 = 16 * seg + i;
            *(bf16*)(lds + H_QT + t0 * H_QS + c * 2) = (bf16)f2bf(qv[i] * 0.08838834764831845f * e0);
            *(bf16*)(lds + H_QT + (t0 + 1) * H_QS + c * 2) = (bf16)f2bf(qv[i + 1] * 0.08838834764831845f * e1);
            *(bf16*)(lds + H_KH + t0 * H_QS + c * 2) = (bf16)f2bf(kk[i] * __expf(-g0));
            *(bf16*)(lds + H_KH + (t0 + 1) * H_QS + c * 2) = (bf16)f2bf(kk[i + 1] * __expf(-g1));
            kbw[i >> 1] = pk2(kk[i] * __expf(tot - g0), kk[i + 1] * __expf(tot - g1));
            vtw[i >> 1] = pk2(vv[i], vv[i + 1]);
        }
        *(u32x4*)(lds + H_KB + c * H_TS + seg * 32) = (u32x4){kbw[0], kbw[1], kbw[2], kbw[3]};
        *(u32x4*)(lds + H_KB + c * H_TS + seg * 32 + 16) = (u32x4){kbw[4], kbw[5], kbw[6], kbw[7]};
        *(u32x4*)(lds + H_VT + c * H_TS + seg * 32) = (u32x4){vtw[0], vtw[1], vtw[2], vtw[3]};
        *(u32x4*)(lds + H_VT + c * H_TS + seg * 32 + 16) = (u32x4){vtw[4], vtw[5], vtw[6], vtw[7]};
        if (ch + 1 < SEQ / 64) { const bf16* pf = proj + (row0 + 64 + 16 * seg) * NINP + h * 128 + c;
#pragma unroll
            for (int i = 0; i < 16; ++i) { zr[i] = pf[(size_t)i * NINP + PC_HF]; qr[i] = pf[(size_t)i * NINP + PC_HQ]; vr[i] = pf[(size_t)i * NINP + PC_HI]; } }
        __syncthreads();
        if (wid < 3) {
            const int atb = wid == 0 ? 0 : 1, asb = wid == 2 ? 1 : 0;
            f32x16 a;
#pragma unroll
            for (int r = 0; r < 16; ++r) a[r] = 0.f;
#pragma unroll
            for (int k8 = 0; k8 < 8; ++k8) {
                const bf16x8 x = *(const bf16x8*)(lds + H_QT + (atb * 32 + r32) * H_QS + (16 * k8 + 8 * hi) * 2);
                const bf16x8 y = *(const bf16x8*)(lds + H_KH + (asb * 32 + r32) * H_QS + (16 * k8 + 8 * hi) * 2);
                a = __builtin_amdgcn_mfma_f32_32x32x16_bf16(x, y, a, 0, 0, 0);
            }
            const int s = asb * 32 + r32;
#pragma unroll
            for (int r = 0; r < 16; ++r) { const int t = atb * 32 + (r & 3) + 8 * (r >> 2) + 4 * hi;
                *(bf16*)(lds + H_A + t * H_TS + s * 2) = (bf16)(s <= t ? f2bf(a[r]) : 0u); }
        }
        f32x16 oacc;
#pragma unroll
        for (int r = 0; r < 16; ++r) oacc[r] = 0.f;
#pragma unroll
        for (int k8 = 0; k8 < 8; ++k8) {
            const bf16x8 x = *(const bf16x8*)(lds + H_QT + (tb * 32 + r32) * H_QS + (16 * k8 + 8 * hi) * 2);
            const bf16x8 y = *(const bf16x8*)(lds + H_ST + (eb * 32 + r32) * H_QS + (16 * k8 + 8 * hi) * 2);
            oacc = __builtin_amdgcn_mfma_f32_32x32x16_bf16(x, y, oacc, 0, 0, 0);
        }
        {
            const float* dec = (const float*)(lds + H_DEC) + db * 32 + 4 * hi;
#pragma unroll
            for (int g4 = 0; g4 < 4; ++g4) { const f32x4 dv = *(const f32x4*)(dec + 8 * g4);
#pragma unroll
                for (int j = 0; j < 4; ++j) { S0[4 * g4 + j] *= dv[j]; S1[4 * g4 + j] *= dv[j]; } }
#pragma unroll
            for (int k4 = 0; k4 < 4; ++k4) {
                const bf16x8 x = *(const bf16x8*)(lds + H_KB + (db * 32 + r32) * H_TS + (16 * k4 + 8 * hi) * 2);
                const bf16x8 y0 = *(const bf16x8*)(lds + H_VT + (eb0 * 32 + r32) * H_TS + (16 * k4 + 8 * hi) * 2);
                const bf16x8 y1 = *(const bf16x8*)(lds + H_VT + ((eb0 + 1) * 32 + r32) * H_TS + (16 * k4 + 8 * hi) * 2);
                S0 = __builtin_amdgcn_mfma_f32_32x32x16_bf16(x, y0, S0, 0, 0, 0);
                S1 = __builtin_amdgcn_mfma_f32_32x32x16_bf16(x, y1, S1, 0, 0, 0);
            }
        }
        __syncthreads();
        {
            const int nk = tb == 0 ? 2 : 4;
            for (int k4 = 0; k4 < nk; ++k4) {
                const bf16x8 x = *(const bf16x8*)(lds + H_A + (tb * 32 + r32) * H_TS + (16 * k4 + 8 * hi) * 2);
                const bf16x8 y = *(const bf16x8*)(lds + H_VT + (eb * 32 + r32) * H_TS + (16 * k4 + 8 * hi) * 2);
                oacc = __builtin_amdgcn_mfma_f32_32x32x16_bf16(x, y, oacc, 0, 0, 0);
            }
#pragma unroll
            for (int r = 0; r < 16; ++r) { const int t = tb * 32 + (r & 3) + 8 * (r >> 2) + 4 * hi; *(float*)(lds + H_O + t * H_OS + (eb * 32 + r32) * 4) = oacc[r]; }
#pragma unroll
            for (int g4 = 0; g4 < 4; ++g4) {
                const int d = db * 32 + 8 * g4 + 4 * hi;
                u32x2 w0, w1; w0.x = pk2(S0[4 * g4], S0[4 * g4 + 1]); w0.y = pk2(S0[4 * g4 + 2], S0[4 * g4 + 3]); w1.x = pk2(S1[4 * g4], S1[4 * g4 + 1]); w1.y = pk2(S1[4 * g4 + 2], S1[4 * g4 + 3]);
                *(u32x2*)(lds + H_ST + (eb0 * 32 + r32) * H_QS + d * 2) = w0;
                *(u32x2*)(lds + H_ST + ((eb0 + 1) * 32 + r32) * H_QS + d * 2) = w1;
            }
        }
        __syncthreads();
        {
            const int t = tid >> 3, e0 = (tid & 7) * 16;
            const float* orow = (const float*)(lds + H_O + t * H_OS) + e0;
            f32x4 ov[4]; float ss = 0.f;
#pragma unroll
            for (int j = 0; j < 4; ++j) { ov[j] = *(const f32x4*)(orow + 4 * j); ss += (ov[j][0] * ov[j][0] + ov[j][1] * ov[j][1]) + (ov[j][2] * ov[j][2] + ov[j][3] * ov[j][3]); }
            ss += __shfl_xor(ss, 1); ss += __shfl_xor(ss, 2); ss += __shfl_xor(ss, 4);
            const float rstd = __builtin_amdgcn_rsqf(ss * (1.f / 128.f) + EPS);
            const bf16* gp = proj + (row0 + t) * NINP + PC_HG + h * 128 + e0;
            const u32x4 gw0 = *(const u32x4*)gp, gw1 = *(const u32x4*)(gp + 8);
            const float* ng = p.hg_g + h * 128 + e0;
            float res[16];
#pragma unroll
            for (int j = 0; j < 16; ++j) { const unsigned wv = j < 8 ? gw0[j >> 1] : gw1[(j - 8) >> 1]; const float gz = bf2f((unsigned short)((j & 1) ? (wv >> 16) : (wv & 0xffffu)));
                const float sl = gz * __builtin_amdgcn_rcpf(1.f + __expf(-gz)); res[j] = ov[j >> 2][j & 3] * rstd * ng[j] * sl; }
            bf16* op = mix + (row0 + t) * DM + 2048 + h * 128 + e0;
            *(u32x4*)op = (u32x4){pk2(res[0], res[1]), pk2(res[2], res[3]), pk2(res[4], res[5]), pk2(res[6], res[7])};
            *(u32x4*)(op + 8) = (u32x4){pk2(res[8], res[9]), pk2(res[10], res[11]), pk2(res[12], res[13]), pk2(res[14], res[15])};
        }
        __syncthreads();
    }
}

__device__ __forceinline__ void convfix_pass(const Params& p, int G) {
    const float* halo = (const float*)(p.ws + WS_HALO); const float* fixb = (const float*)(p.ws + WS_FIX); bf16* act = (bf16*)(p.ws + WS_ACT);
    const int gt = blockIdx.x * NTHR + threadIdx.x, NGT = G * NTHR;
    for (int w = gt; w < 64 * 86 * 2 * 128; w += NGT) {
        const int c = w & 127, i = (w >> 7) & 1, tile = w >> 8, pn = tile % 86, pm = tile / 86, ch = pn * 128 + c, t = pm * 256 + i;
        const float cpart = fixb[((size_t)tile * 2 + i) * 256 + c], up = fixb[((size_t)tile * 2 + i) * 256 + 128 + c];
        float h0 = 0.f, h1 = 0.f;
        if ((pm & 31) != 0) { const size_t hb = ((size_t)((pm - 1) * 86 + pn) * 2) * 128 + c; h0 = halo[hb]; h1 = halo[hb + 128]; }
        const float w0 = p.conv_w[ch], w1 = p.conv_w[DFF + ch];
        const float cv = cpart + (i == 0 ? w0 * h0 + w1 * h1 : w0 * h1);
        act[(size_t)t * DFF + ch] = (bf16)f2bf(cv / (1.f + __expf(-cv)) * up);
    }
}

__device__ __forceinline__ void final_pass(const Params& p, int G) {
    const float* ctl = (const float*)(p.ws + WS_CTL); const bf16* h2b = (const bf16*)(p.ws + WS_H2B);
    const int lane = threadIdx.x & 63, gw = blockIdx.x * NWAVES + (threadIdx.x >> 6), NGW = G * NWAVES;
    for (int m = gw; m < T; m += NGW) {
        const float rstd = __builtin_amdgcn_rsqf(ctl[CF_SS3 + m] * (1.f / DM) + EPS);
        const u32x4* hr = (const u32x4*)(h2b + (size_t)m * DM) + lane; f32x4* xr = (f32x4*)(p.out + (size_t)m * DM) + 2 * lane; const f32x4* gr = (const f32x4*)p.fin_g + 2 * lane;
        u32x4 hv[8];
#pragma unroll
        for (int j = 0; j < 8; ++j) hv[j] = hr[64 * j];
#pragma unroll
        for (int j = 0; j < 8; ++j) { const u32x4 w = hv[j]; const f32x4 g0 = gr[128 * j], g1 = gr[128 * j + 1];
            const f32x4 v0 = (f32x4){__builtin_bit_cast(float, w.x << 16), __builtin_bit_cast(float, w.x & 0xffff0000u), __builtin_bit_cast(float, w.y << 16), __builtin_bit_cast(float, w.y & 0xffff0000u)};
            const f32x4 v1 = (f32x4){__builtin_bit_cast(float, w.z << 16), __builtin_bit_cast(float, w.z & 0xffff0000u), __builtin_bit_cast(float, w.w << 16), __builtin_bit_cast(float, w.w & 0xffff0000u)};
            __builtin_nontemporal_store(v0 * rstd * g0, xr + 128 * j); __builtin_nontemporal_store(v1 * rstd * g1, xr + 128 * j + 1); }
    }
}

#define XB_TMO      128
#define XB_XCNT(j)  (256  + 64 * (j))
#define XB_XSUB(j)  (1280 + 64 * (j))
#define XB_XGEN(j)  (2304 + 64 * (j))
#define XB_TOP      3328
#define XB_TOPGEN   3392
#define XCD_BAR_WORDS 3456
#define XB_SPIN_CAP (1u << 18)
__device__ __forceinline__ unsigned xb_ld(unsigned* p)              { return __hip_atomic_load(p, __ATOMIC_RELAXED, __HIP_MEMORY_SCOPE_AGENT); }
__device__ __forceinline__ unsigned xb_add(unsigned* p, unsigned v) { return __hip_atomic_fetch_add(p, v, __ATOMIC_RELAXED, __HIP_MEMORY_SCOPE_AGENT); }
__device__ __forceinline__ unsigned xb_xcc_id() { return (unsigned)__builtin_amdgcn_s_getreg((3 << 11) | 20) & 0xFu; }
#define XB_SPIN(cond, bar) do { unsigned _sp = 0; while (cond) { __builtin_amdgcn_s_sleep(1); \
    if ((++_sp & 255u) == 0u) { if (xb_ld(&(bar)[XB_TMO])) break; if (_sp > XB_SPIN_CAP) { atomicAdd(&(bar)[XB_TMO], 1u); break; } } } } while (0)
struct XcdBarrier { unsigned* bar; unsigned x; volatile LAS unsigned* st; };
__device__ __forceinline__ XcdBarrier xcd_barrier_post(unsigned* bar, volatile LAS unsigned* st) {
    XcdBarrier b; b.bar = bar; b.x = xb_xcc_id(); b.st = st;
    if (threadIdx.x == 0) (void)xb_add(&bar[XB_XCNT(b.x)], 1u);
    return b;
}
__device__ __forceinline__ void xcd_barrier_complete(unsigned* bar, unsigned x, unsigned& nloc, unsigned& nx) {
    const unsigned G = gridDim.x * gridDim.y * gridDim.z;
    unsigned sum, cnt, mine, sp = 0u;
    for (;;) {
        sum = 0u; cnt = 0u; mine = 0u;
#pragma unroll
        for (unsigned j = 0; j < 16; ++j) { const unsigned c = xb_ld(&bar[XB_XCNT(j)]); sum += c; cnt += (c > 0u) ? 1u : 0u; mine = (j == x) ? c : mine; }
        if (sum == G) break;
        __builtin_amdgcn_s_sleep(1);
        if ((++sp & 255u) == 0u) { if (xb_ld(&bar[XB_TMO])) break; if (sp > XB_SPIN_CAP) { atomicAdd(&bar[XB_TMO], 1u); break; } }
    }
    nloc = mine > 0u ? mine : 1u; nx = cnt > 0u ? cnt : 1u;
}
__device__ __forceinline__ void xcd_barrier(const XcdBarrier& b) {
    asm volatile("s_waitcnt vmcnt(0)" ::: "memory");
    __syncthreads();
    if (threadIdx.x == 0) {
        unsigned* bar = b.bar;
        __builtin_amdgcn_s_waitcnt(0);
        unsigned nloc = b.st[0], nx = b.st[1];
        if (nloc == 0u) { xcd_barrier_complete(bar, b.x, nloc, nx); b.st[0] = nloc; b.st[1] = nx; }
        const unsigned old = xb_add(&bar[XB_XSUB(b.x)], 1u);
        const unsigned gen = old / nloc;
        if (old + 1u == (gen + 1u) * nloc) {
            __builtin_amdgcn_fence(__ATOMIC_RELEASE, "agent");
            asm volatile("s_waitcnt vmcnt(0)" ::: "memory");
            const unsigned og = xb_add(&bar[XB_TOP], 1u);
            const unsigned tg = og / nx;
            if (og + 1u == (tg + 1u) * nx) xb_add(&bar[XB_TOPGEN], 1u);
            else XB_SPIN(xb_ld(&bar[XB_TOPGEN]) == tg, bar);
            __builtin_amdgcn_fence(__ATOMIC_ACQUIRE, "agent");
            xb_add(&bar[XB_XGEN(b.x)], 1u);
            asm volatile("s_waitcnt vmcnt(0)" ::: "memory");
        } else {
            XB_SPIN(xb_ld(&bar[XB_XGEN(b.x)]) == gen, bar);
            __builtin_amdgcn_fence(__ATOMIC_ACQUIRE, "agent");
            asm volatile("s_waitcnt vmcnt(0)" ::: "memory");
        }
    }
    __syncthreads();
}
constexpr size_t WS_BAR = 524288;

__global__ void __launch_bounds__(NTHR, 2) fwd_kernel(Params p) {
    extern __shared__ __attribute__((aligned(16))) unsigned char lds[];
    LAS unsigned char* ldsl = (LAS unsigned char*)lds;
    const int G = gridDim.x;
    unsigned char* ws = p.ws; float* ctl = (float*)(ws + WS_CTL);
    const int lo = p.ph_lo, hi = p.ph_hi;
#if ONE_LAUNCH
    volatile LAS unsigned* xst = (volatile LAS unsigned*)(ldsl + LDS_BYTES - 32);
    if (threadIdx.x < 2) xst[threadIdx.x] = 0u;
    __syncthreads();
    const XcdBarrier xbar = xcd_barrier_post((unsigned*)(ws + WS_BAR), xst);
#endif
#define IN(k) (lo <= (k) && (k) < hi)
#if ONE_LAUNCH
#define SEAM(k) do { if (IN(k) && IN((k) + 1)) { if (lo < 0) { __threadfence(); cg::this_grid().sync(); __threadfence(); } xcd_barrier(xbar); } } while (0)
#else
#define SEAM(k) do { } while (0)
#endif
    if (IN(0)) { p0_prologue(p, ldsl, G); }
    SEAM(0);
    if (IN(1)) {
        pg8::Gemm g{(const bf16*)(ws + WS_XB), (const bf16*)(ws + WS_WIN), T, NINP, DM, DM, DM}; pg8::StaticOrder S; S.init(T, NINP, G, (int)blockIdx.x);
        pg8::EpiScaleBf16<false, true> E{(bf16*)(ws + WS_PROJ), NINP, ctl + CF_SS1, 1.f / DM, EPS, 1.f, ctl + CF_SSQ, ctl + CF_SSKV};
        pg8::gemm_phase(ldsl, g, S, E);
        transpose_in_idle_round(p, ldsl, IT_EARLY, IT_MID, (T / 256) * (NINP / 256), G);
    }
    SEAM(1);
    if (IN(2)) {
        { pg8::Gemm g{(const bf16*)(ws + WS_PROJ) + PC_CQ, (const bf16*)(ws + WS_WUQ), T, NQ, 768, NINP, 768}; pg8::StaticOrder S; S.init(T, NQ, G, (int)blockIdx.x);
          pg8::EpiScaleBf16<false, false> E{(bf16*)(ws + WS_Q), NQ, ctl + CF_SSQ, 1.f / 768.f, EPS, C2, nullptr, nullptr};
          pg8::gemm_phase(ldsl, g, S, E); }
        { pg8::Gemm g{(const bf16*)(ws + WS_PROJ) + PC_CKV, (const bf16*)(ws + WS_WKV), T, NKN, 512, NINP, 512}; pg8::StaticOrder S; S.init(T, NKN, G, (int)blockIdx.x);
          pg8::EpiScaleBf16<false, false> E{(bf16*)(ws + WS_KN), NKN, ctl + CF_SSKV, 1.f / 512.f, EPS, 1.f, nullptr, nullptr};
          pg8::gemm_phase(ldsl, g, S, E); }
        { pg8::Gemm g{(const bf16*)(ws + WS_WKV) + (size_t)2048 * 512, (const bf16*)(ws + WS_PROJ) + PC_CKV, 2048, T, 512, 512, NINP}; pg8::StaticOrder S; S.init(2048, T, G, (int)blockIdx.x);
          pg8::EpiScaleBf16<true, false> E{(bf16*)(ws + WS_VT), T, ctl + CF_SSKV, 1.f / 512.f, EPS, 1.f, nullptr, nullptr};
          pg8::gemm_phase(ldsl, g, S, E); }
        krope_pass(p, G);
    }
    SEAM(2);
    if (IN(3)) {
        if (blockIdx.x < 32 || G < 32) { for (int s = blockIdx.x; s < 32; s += G) hgrn_stream(p, s >> 4, s & 15, lds); }
        unsigned* qc = (unsigned*)(ctl + CF_QCNT);
        LAS unsigned* slot = (LAS unsigned*)(ldsl + LDS_BYTES - 16);
        for (;;) {
            if (threadIdx.x == 0) *slot = atomicAdd(qc, 1u);
            __syncthreads();
            const unsigned u = *slot;
            __syncthreads();
            if (u >= 1024u) break;
            const int qb = 31 - (int)(u >> 5), bh = (int)(u & 31);
            attn_unit(p, bh >> 4, bh & 15, qb, lds);
        }
    }
    SEAM(3);
    if (IN(4)) {
        pg8::Gemm g{(const bf16*)(ws + WS_MIX), (const bf16*)(ws + WS_WOUT), T, DM, DM, DM, DM}; pg8::StaticOrder S; S.init(T, DM, G, (int)blockIdx.x);
        pg8::EpiRes<0> E{p.x, nullptr, nullptr, (bf16*)(ws + WS_H1B), DM, ctl + CF_SS2};
        pg8::gemm_phase(ldsl, g, S, E);
    }
    SEAM(4);
    if (IN(5)) {
        pg8::Gemm g{(const bf16*)(ws + WS_H1B), (const bf16*)(ws + WS_WUP), T, NUP, DM, DM, DM}; pg8::StaticOrder S; S.init(T, NUP, G, (int)blockIdx.x);
        pg8::EpiConvGlu E{(bf16*)(ws + WS_ACT), DFF, ctl + CF_SS2, 1.f / DM, EPS, p.conv_w, p.conv_b, DFF, (float*)(ws + WS_HALO), (float*)(ws + WS_FIX), (LAS float*)(ldsl + 131072), NUP / 256};
        pg8::gemm_phase(ldsl, g, S, E);
        transpose_in_idle_round(p, ldsl, IT_MID, IT_ALL, (T / 256) * (NUP / 256), G);
    }
    SEAM(5);
    if (IN(6)) { convfix_pass(p, G); }
    SEAM(6);
    if (IN(7)) {
        pg8::Gemm g{(const bf16*)(ws + WS_ACT), (const bf16*)(ws + WS_WDOWN), T, DM, DFF, DFF, DFF}; pg8::StaticOrder S; S.init(T, DM, G, (int)blockIdx.x);
        pg8::EpiRes<1> E{nullptr, (const bf16*)(ws + WS_H1B), nullptr, (bf16*)(ws + WS_H2B), DM, ctl + CF_SS3};
        pg8::gemm_phase(ldsl, g, S, E);
    }
    SEAM(7);
    if (IN(8)) { final_pass(p, G); }
#undef IN
#undef SEAM
}

constexpr int N_PHASES = 9;

extern "C" void kernel_launch(void* const* d_in, const int* in_sizes, int n_in, void* d_out, int out_size, void* d_ws, size_t ws_size, hipStream_t stream) {
    static int grid = 0;
    if (grid == 0) {
        if (n_in != 18 || in_sizes[0] != T * DM || out_size != T * DM || ws_size < WS_END) { fprintf(stderr, "kernel_launch: unexpected shapes / workspace (n_in %d, ws %zu, need %zu)\n", n_in, ws_size, (size_t)WS_END); grid = -1; return; }
        int dev = 0, cus = 0, per_cu = 0;
        hipGetDevice(&dev); hipDeviceGetAttribute(&cus, hipDeviceAttributeMultiprocessorCount, dev);
        if (hipFuncSetAttribute((const void*)fwd_kernel, hipFuncAttributeMaxDynamicSharedMemorySize, LDS_BYTES) != hipSuccess) { fprintf(stderr, "kernel_launch: hipFuncSetAttribute failed\n"); grid = -1; return; }
        hipOccupancyMaxActiveBlocksPerMultiprocessor(&per_cu, (const void*)fwd_kernel, NTHR, LDS_BYTES);
        (void)hipGetLastError();
        if (per_cu < 1) { fprintf(stderr, "kernel_launch: occupancy query says %d blocks per CU\n", per_cu); per_cu = 1; }
        grid = cus > 0 ? cus : 256;
    }
    if (grid < 0) return;
    Params p{};
    p.x = (const float*)d_in[0]; p.pos = (const int*)d_in[1]; p.mix_g = (const float*)d_in[2]; p.w_in = (const float*)d_in[3]; p.qn_g = (const float*)d_in[4];
    p.w_uq = (const float*)d_in[5]; p.kvn_g = (const float*)d_in[6]; p.w_ukv = (const float*)d_in[7]; p.attn_g = (const float*)d_in[8]; p.lb = (const float*)d_in[9];
    p.hg_g = (const float*)d_in[10]; p.w_out = (const float*)d_in[11]; p.ffn_g = (const float*)d_in[12]; p.w_up = (const float*)d_in[13]; p.conv_w = (const float*)d_in[14];
    p.conv_b = (const float*)d_in[15]; p.w_down = (const float*)d_in[16]; p.fin_g = (const float*)d_in[17]; p.out = (float*)d_out; p.ws = (unsigned char*)d_ws;
#if ONE_LAUNCH
    p.ph_lo = 0; p.ph_hi = N_PHASES;
    if (hipMemsetAsync((char*)d_ws + WS_BAR, 0, 16384, stream) != hipSuccess) { fprintf(stderr, "kernel_launch: hipMemsetAsync failed\n"); return; }
    void* args[] = {&p};
    hipError_t e = hipLaunchCooperativeKernel((const void*)fwd_kernel, dim3(grid), dim3(NTHR), args, LDS_BYTES, stream);
    if (e != hipSuccess) fprintf(stderr, "cooperative launch failed: %s (grid %d)\n", hipGetErrorString(e), grid);
#else
    for (int ph = 0; ph < N_PHASES; ++ph) { p.ph_lo = ph; p.ph_hi = ph + 1; hipLaunchKernelGGL(fwd_kernel, dim3(grid), dim3(NTHR), LDS_BYTES, stream, p); }
#endif
}
```

```cpp
#include <hip/hip_runtime.h>
#include <hip/hip_cooperative_groups.h>
#include <cstdio>
#include <cstdint>
namespace cg = cooperative_groups;

#ifndef ONE_LAUNCH
#define ONE_LAUNCH 1
#endif

namespace pg8 {
#define PG8_LAS __attribute__((address_space(3)))
typedef unsigned short bf16_t;
typedef short bf16x8 __attribute__((ext_vector_type(8)));
typedef float f32x4 __attribute__((ext_vector_type(4)));
typedef unsigned u32x4 __attribute__((ext_vector_type(4)));
constexpr int BM = 256, BK = 64, HALF = 128, HTB = HALF * BK * 2, STAGE_BYTES = 8 * HTB, NXCD = 8, WGM = 8;

__host__ __device__ __forceinline__ int lds_byte(int r, int c) { const int st = (r >> 4) * 2 + (c >> 5), rr = r & 15, cc = c & 31, ob = rr * 64 + cc * 2; return st * 1024 + (ob ^ (((ob >> 9) & 1) << 5)); }
__host__ __device__ __forceinline__ void stage_rc(int b, int& R, int& C) { const int st = b / 1024, sb = b % 1024, swz = sb ^ (((sb >> 9) & 1) << 5); R = (st >> 1) * 16 + swz / 64; C = (st & 1) * 32 + (swz % 64) / 2; }
__host__ __device__ __forceinline__ int perm32(int rho) { const int n = rho >> 4, i = rho & 15; return 8 * (i >> 2) + 4 * n + (i & 3); }

struct Unit { int pm, pn; };
struct Gemm { const bf16_t* A; const bf16_t* Bt; int M, N, K, lda, ldb; };

struct StaticOrder {
    int nM, nN, nwg, G, c;
    __host__ __device__ void init(int M, int N, int G_, int c_) { nM = M / BM; nN = N / BM; nwg = nM * nN; G = G_; c = c_; }
    __host__ __device__ bool next(int i, Unit& u) const {
        const long L = (long)i * G + c; if (L >= nwg) return false;
        int wgid = (int)L; { const int q = nwg / NXCD, r = nwg % NXCD, xcd = wgid % NXCD, off = wgid / NXCD; wgid = (xcd < r ? xcd * (q + 1) : r * (q + 1) + (xcd - r) * q) + off; }
        const int nig = WGM * nN, gid = wgid / nig, fm = gid * WGM, gsz = (nM - fm) < WGM ? (nM - fm) : WGM;
        u.pm = fm + ((wgid % nig) % gsz); u.pn = (wgid % nig) / gsz; return true;
    }
};

typedef float f32x2_t __attribute__((ext_vector_type(2))); typedef __bf16 bf16x2_t __attribute__((ext_vector_type(2)));
__device__ __forceinline__ unsigned cvt_pk_bf16(float lo, float hi) { f32x2_t v = {lo, hi}; bf16x2_t b = __builtin_convertvector(v, bf16x2_t); return __builtin_bit_cast(unsigned, b); }

template <bool COLSCALE, bool SSOUT> struct EpiScaleBf16 {
    bf16_t* O; int ldc; const float* ssin; float inv_n, eps, cs; float* ssq; float* sskv;
    __device__ __forceinline__ void operator()(const f32x4 (&acc)[2][2][4][2], const Unit& u, int wr, int wc, int fr, int fq) const {
        const int row0 = u.pm * BM + wr * 64 + fr, col0 = u.pn * BM + wc * 32 + 8 * fq;
        f32x4 csv[2][2];
        if (COLSCALE) {
#pragma unroll
            for (int bj = 0; bj < 2; ++bj)
#pragma unroll
                for (int n = 0; n < 2; ++n) { const f32x4 s = *(const f32x4*)(ssin + col0 + bj * HALF + 4 * n);
#pragma unroll
                    for (int j = 0; j < 4; ++j) csv[bj][n][j] = __builtin_amdgcn_rsqf(s[j] * inv_n + eps) * cs; }
        }
#pragma unroll
        for (int ai = 0; ai < 2; ++ai)
#pragma unroll
            for (int m = 0; m < 4; ++m) {
                const int row = row0 + ai * HALF + m * 16;
                float rs = 1.f; if (!COLSCALE) rs = __builtin_amdgcn_rsqf(ssin[row] * inv_n + eps) * cs;
                float sq = 0.f;
                bf16_t* rowp = O + (size_t)row * ldc + col0;
#pragma unroll
                for (int bj = 0; bj < 2; ++bj) {
                    f32x4 v0 = acc[ai][bj][m][0], v1 = acc[ai][bj][m][1];
                    if (COLSCALE) { v0 = v0 * csv[bj][0]; v1 = v1 * csv[bj][1]; } else { v0 = v0 * rs; v1 = v1 * rs; }
                    if (SSOUT) sq += (v0[0] * v0[0] + v0[1] * v0[1]) + (v0[2] * v0[2] + v0[3] * v0[3]) + (v1[0] * v1[0] + v1[1] * v1[1]) + (v1[2] * v1[2] + v1[3] * v1[3]);
                    u32x4 w; w.x = cvt_pk_bf16(v0[0], v0[1]); w.y = cvt_pk_bf16(v0[2], v0[3]); w.z = cvt_pk_bf16(v1[0], v1[1]); w.w = cvt_pk_bf16(v1[2], v1[3]);
                    *(u32x4*)(rowp + bj * HALF) = w;
                }
                if (SSOUT) { if (u.pn < 5) { sq += __shfl_xor(sq, 16); sq += __shfl_xor(sq, 32); if (fq == 0) atomicAdd((u.pn < 3 ? ssq : sskv) + row, sq); } }
            }
    }
};
template <int MODE> struct EpiRes {
    const float* basef; const bf16_t* baseb; float* out; bf16_t* ob; int ldc; float* ss;
    __device__ __forceinline__ void operator()(const f32x4 (&acc)[2][2][4][2], const Unit& u, int wr, int wc, int fr, int fq) const {
        const int row0 = u.pm * BM + wr * 64 + fr, col0 = u.pn * BM + wc * 32 + 8 * fq;
#pragma unroll
        for (int ai = 0; ai < 2; ++ai)
#pragma unroll
            for (int m = 0; m < 4; ++m) {
                const int row = row0 + ai * HALF + m * 16; float sq = 0.f;
#pragma unroll
                for (int bj = 0; bj < 2; ++bj) {
                    const size_t p = (size_t)row * ldc + col0 + bj * HALF;
                    f32x4 b0, b1;
                    { const u32x4 w = *(const u32x4*)(baseb + p);
                        b0 = (f32x4){__builtin_bit_cast(float, w.x << 16), __builtin_bit_cast(float, w.x & 0xffff0000u), __builtin_bit_cast(float, w.y << 16), __builtin_bit_cast(float, w.y & 0xffff0000u)};
                        b1 = (f32x4){__builtin_bit_cast(float, w.z << 16), __builtin_bit_cast(float, w.z & 0xffff0000u), __builtin_bit_cast(float, w.w << 16), __builtin_bit_cast(float, w.w & 0xffff0000u)}; }
                    const f32x4 v0 = acc[ai][bj][m][0] + b0, v1 = acc[ai][bj][m][1] + b1;
                    if (MODE == 0) { u32x4 w; w.x = cvt_pk_bf16(v0[0], v0[1]); w.y = cvt_pk_bf16(v0[2], v0[3]); w.z = cvt_pk_bf16(v1[0], v1[1]); w.w = cvt_pk_bf16(v1[2], v1[3]); *(u32x4*)(ob + p) = w; }
                    else { u32x4 w; w.x = cvt_pk_bf16(v0[0], v0[1]); w.y = cvt_pk_bf16(v0[2], v0[3]); w.z = cvt_pk_bf16(v1[0], v1[1]); w.w = cvt_pk_bf16(v1[2], v1[3]); *(u32x4*)(ob + p) = w; }
                    sq += (v0[0] * v0[0] + v0[1] * v0[1]) + (v0[2] * v0[2] + v0[3] * v0[3]) + (v1[0] * v1[0] + v1[1] * v1[1]) + (v1[2] * v1[2] + v1[3] * v1[3]);
                }
                sq += __shfl_xor(sq, 16); sq += __shfl_xor(sq, 32); if (fq == 0) atomicAdd(ss + row, sq);
            }
    }
};

__device__ __forceinline__ float dpp_ror1(float v) { return __builtin_bit_cast(float, __builtin_amdgcn_mov_dpp(__builtin_bit_cast(int, v), 0x121, 0xf, 0xf, true)); }
__device__ __forceinline__ float dpp_ror2(float v) { return __builtin_bit_cast(float, __builtin_amdgcn_mov_dpp(__builtin_bit_cast(int, v), 0x122, 0xf, 0xf, true)); }
struct EpiConvGlu {
    bf16_t* act; int ldc; const float* ssin; float inv_n, eps; const float* cw; const float* cb; int dff; float* halo_g; float* fixb; PG8_LAS float* hl; int ntn;
    __device__ __forceinline__ void operator()(const f32x4 (&acc)[2][2][4][2], const Unit& u, int wr, int wc, int fr, int fq) const {
        const int cl = wc * 32 + 8 * fq, ch0 = u.pn * 128 + cl;
        float w0[8], w1[8], w2[8], bb[8];
#pragma unroll
        for (int n = 0; n < 2; ++n) { const f32x4 a = *(const f32x4*)(cw + ch0 + 4 * n), b = *(const f32x4*)(cw + dff + ch0 + 4 * n), c = *(const f32x4*)(cw + 2 * dff + ch0 + 4 * n), d = *(const f32x4*)(cb + ch0 + 4 * n);
#pragma unroll
            for (int j = 0; j < 4; ++j) { w0[4 * n + j] = a[j]; w1[4 * n + j] = b[j]; w2[4 * n + j] = c[j]; bb[4 * n + j] = d[j]; } }
        const int row0 = u.pm * BM + wr * 64 + fr;
        float rs[2][4];
#pragma unroll
        for (int ai = 0; ai < 2; ++ai)
#pragma unroll
            for (int m = 0; m < 4; ++m) rs[ai][m] = __builtin_amdgcn_rsqf(ssin[row0 + ai * HALF + m * 16] * inv_n + eps);
        if (fr >= 14) {
#pragma unroll
            for (int ai = 0; ai < 2; ++ai) {
                const f32x4 g0 = acc[ai][0][3][0] * rs[ai][3], g1 = acc[ai][0][3][1] * rs[ai][3];
                PG8_LAS float* hp = hl + ((wr * 2 + ai) * 2 + (fr - 14)) * 128 + cl;
                *(PG8_LAS f32x4*)hp = g0; *(PG8_LAS f32x4*)(hp + 4) = g1;
                if (wr == 1 && ai == 1) { float* gp = halo_g + ((size_t)(u.pm * ntn + u.pn) * 2 + (fr - 14)) * 128 + cl; *(f32x4*)gp = g0; *(f32x4*)(gp + 4) = g1; }
            }
        }
        asm volatile("s_waitcnt lgkmcnt(0)" ::: "memory"); __builtin_amdgcn_s_barrier(); asm volatile("" ::: "memory");
#pragma unroll
        for (int ai = 0; ai < 2; ++ai) {
            float prev[8];
#pragma unroll
            for (int k = 0; k < 8; ++k) prev[k] = 0.f;
            const bool tile_first = (wr == 0 && ai == 0);
            if (fr >= 14 && !tile_first) {
                const int swr = wr == 1 ? 0 : 1, sai = wr == 1 ? ai : 0;
                const PG8_LAS float* hp = hl + ((swr * 2 + sai) * 2 + (fr - 14)) * 128 + cl;
                const f32x4 h0 = *(const PG8_LAS f32x4*)hp, h1 = *(const PG8_LAS f32x4*)(hp + 4);
#pragma unroll
                for (int j = 0; j < 4; ++j) { prev[j] = h0[j]; prev[4 + j] = h1[j]; }
            }
#pragma unroll
            for (int m = 0; m < 4; ++m) {
                const int row = row0 + ai * HALF + m * 16;
                const f32x4 gv0 = acc[ai][0][m][0] * rs[ai][m], gv1 = acc[ai][0][m][1] * rs[ai][m], uv0 = acc[ai][1][m][0] * rs[ai][m], uv1 = acc[ai][1][m][1] * rs[ai][m];
                float gm[8], res[8], cv[8];
#pragma unroll
                for (int j = 0; j < 4; ++j) { gm[j] = gv0[j]; gm[4 + j] = gv1[j]; }
#pragma unroll
                for (int k = 0; k < 8; ++k) {
                    const float a1 = dpp_ror1(gm[k]), b1 = dpp_ror1(prev[k]), a2 = dpp_ror2(gm[k]), b2 = dpp_ror2(prev[k]);
                    const float p1 = fr >= 1 ? a1 : b1, p2 = fr >= 2 ? a2 : b2;
                    cv[k] = bb[k] + w0[k] * p2 + w1[k] * p1 + w2[k] * gm[k];
                    const float uu = k < 4 ? uv0[k & 3] : uv1[k & 3];
                    res[k] = cv[k] * __builtin_amdgcn_rcpf(1.f + __expf(-cv[k])) * uu;
                }
                if (tile_first && m == 0 && fr < 2) {
                    float* fp = fixb + (((size_t)(u.pm * ntn + u.pn) * 2 + fr) * 2) * 128 + cl;
                    *(f32x4*)fp = (f32x4){cv[0], cv[1], cv[2], cv[3]}; *(f32x4*)(fp + 4) = (f32x4){cv[4], cv[5], cv[6], cv[7]};
                    *(f32x4*)(fp + 128) = uv0; *(f32x4*)(fp + 132) = uv1;
                } else {
                    u32x4 w; w.x = cvt_pk_bf16(res[0], res[1]); w.y = cvt_pk_bf16(res[2], res[3]); w.z = cvt_pk_bf16(res[4], res[5]); w.w = cvt_pk_bf16(res[6], res[7]);
                    *(u32x4*)(act + (size_t)row * ldc + ch0) = w;
                }
#pragma unroll
                for (int k = 0; k < 8; ++k) prev[k] = gm[k];
            }
        }
    }
};

template <class Epi, class Sched>
__device__ __forceinline__ void gemm_phase(PG8_LAS unsigned char* lds, const Gemm g, const Sched& S, const Epi& E) {
    const int tid = threadIdx.x, wid = __builtin_amdgcn_readfirstlane(tid >> 6), lane = tid & 63, wr = wid >> 2, wc = wid & 3, fr = lane & 15, fq = lane >> 4;
    const int K = g.K, nt = K / BK;
    unsigned voffA[2], voffB[2];
#pragma unroll
    for (int i = 0; i < 2; ++i) { int R, C; stage_rc(tid * 16 + i * 8192, R, C); const int Rb = (R & ~31) + perm32(R & 31);
        voffA[i] = (unsigned)(R * g.lda + C) * 2u; voffB[i] = (unsigned)(Rb * g.ldb + C) * 2u; }
    const size_t kstep = (size_t)(BK * 2);
    const size_t hstepA = (size_t)HALF * g.lda * 2, hstepB = (size_t)HALF * g.ldb * 2;
    const size_t tstepA = 2 * hstepA, tstepB = 2 * hstepB;
    const unsigned ldsw = (unsigned)wid * 1024u;
    const int aoff = lds_byte(wr * 64 + fr, fq * 8), boff = lds_byte(wc * 32 + fr, fq * 8);
#define PG8_SA(b, h) (((b) * 2 + (h)) * HTB)
#define PG8_SB(b, h) ((4 + (b) * 2 + (h)) * HTB)
#define PG8_STAGE(bufoff, gbase, voff) do { _Pragma("unroll") for (int _i = 0; _i < 2; ++_i) \
        __builtin_amdgcn_global_load_lds((const unsigned*)((const char*)(gbase) + (voff)[_i]), (PG8_LAS unsigned*)(lds + (bufoff) + ldsw + _i * 8192), 16, 0, 0); } while (0)
#define PG8_LDA(dst, b, h) do { _Pragma("unroll") for (int m = 0; m < 4; ++m) _Pragma("unroll") for (int k = 0; k < 2; ++k) dst[m][k] = *(const PG8_LAS bf16x8*)(lds + PG8_SA(b, h) + aoff + m * 2048 + k * 1024); } while (0)
#define PG8_LDB(dst, b, h) do { _Pragma("unroll") for (int n = 0; n < 2; ++n) _Pragma("unroll") for (int k = 0; k < 2; ++k) dst[n][k] = *(const PG8_LAS bf16x8*)(lds + PG8_SB(b, h) + boff + n * 2048 + k * 1024); } while (0)
#define PG8_MMA(ai, bj, At, Bt) do { __builtin_amdgcn_s_setprio(1); _Pragma("unroll") for (int m = 0; m < 4; ++m) _Pragma("unroll") for (int n = 0; n < 2; ++n) _Pragma("unroll") for (int k = 0; k < 2; ++k) \
        acc[ai][bj][m][n] = __builtin_amdgcn_mfma_f32_16x16x32_bf16(Bt[n][k], At[m][k], acc[ai][bj][m][n], 0, 0, 0); __builtin_amdgcn_s_setprio(0); } while (0)
#define PG8_WAIT_V(n) asm volatile("s_waitcnt vmcnt(" #n ")" ::: "memory")
#define PG8_WAIT_L(n) asm volatile("s_waitcnt lgkmcnt(" #n ")" ::: "memory")
#define PG8_BAR __builtin_amdgcn_s_barrier()
#define PG8_SCHED __builtin_amdgcn_sched_barrier(0)
    Unit cur, nxt; int ui = 0;
    if (!S.next(0, cur)) return;
    f32x4 acc[2][2][4][2];
#pragma unroll
    for (int a = 0; a < 2; ++a)
#pragma unroll
        for (int b = 0; b < 2; ++b)
#pragma unroll
            for (int m = 0; m < 4; ++m)
#pragma unroll
                for (int n = 0; n < 2; ++n) acc[a][b][m][n] = (f32x4){0.f, 0.f, 0.f, 0.f};
    bf16x8 At[4][2], B0[2][2], B1[2][2];
    const char* cA = (const char*)g.A + (size_t)cur.pm * tstepA; const char* cB = (const char*)g.Bt + (size_t)cur.pn * tstepB;
    PG8_STAGE(PG8_SB(0, 0), cB, voffB); PG8_STAGE(PG8_SB(0, 1), cB + hstepB, voffB); PG8_STAGE(PG8_SA(0, 0), cA, voffA); PG8_STAGE(PG8_SA(0, 1), cA + hstepA, voffA);
    if (wr == 1) PG8_BAR;
    PG8_WAIT_V(2); PG8_BAR;
    PG8_STAGE(PG8_SB(1, 0), cB + kstep, voffB); PG8_STAGE(PG8_SA(1, 0), cA + kstep, voffA); PG8_STAGE(PG8_SB(1, 1), cB + hstepB + kstep, voffB);
    PG8_WAIT_V(6); PG8_BAR;
    for (;;) {
        const bool has_next = S.next(ui + 1, nxt);
        const char* nA = has_next ? (const char*)g.A + (size_t)nxt.pm * tstepA : cA; const char* nB = has_next ? (const char*)g.Bt + (size_t)nxt.pn * tstepB : cB;
        for (int t = 0; t < nt; t += 2) {
            const bool last = (t == nt - 2);
            const char* a1 = cA + (size_t)(t + 1) * kstep;
            const char* a2 = last ? nA : cA + (size_t)(t + 2) * kstep; const char* b2 = last ? nB : cB + (size_t)(t + 2) * kstep;
            const char* a3 = a2 + kstep; const char* b3 = b2 + kstep;
            PG8_LDB(B0, 0, 0); PG8_LDB(B1, 0, 1); PG8_SCHED; PG8_LDA(At, 0, 0); PG8_STAGE(PG8_SA(1, 1), a1 + hstepA, voffA);
            PG8_WAIT_V(8); PG8_WAIT_L(0); PG8_BAR; PG8_MMA(0, 0, At, B0); PG8_MMA(0, 1, At, B1); PG8_BAR; PG8_SCHED;
            PG8_LDA(At, 0, 1); PG8_STAGE(PG8_SB(0, 0), b2, voffB); PG8_STAGE(PG8_SB(0, 1), b2 + hstepB, voffB); PG8_STAGE(PG8_SA(0, 0), a2, voffA);
            PG8_WAIT_V(8); PG8_WAIT_L(0); PG8_BAR; PG8_MMA(1, 0, At, B0); PG8_MMA(1, 1, At, B1); PG8_BAR; PG8_SCHED;
            PG8_LDB(B0, 1, 0); PG8_LDB(B1, 1, 1); PG8_SCHED; PG8_LDA(At, 1, 0); PG8_STAGE(PG8_SA(0, 1), a2 + hstepA, voffA);
            PG8_WAIT_V(8); PG8_WAIT_L(0); PG8_BAR; PG8_MMA(0, 0, At, B0); PG8_MMA(0, 1, At, B1); PG8_BAR; PG8_SCHED;
            PG8_LDA(At, 1, 1); PG8_STAGE(PG8_SB(1, 0), b3, voffB); PG8_STAGE(PG8_SB(1, 1), b3 + hstepB, voffB); PG8_STAGE(PG8_SA(1, 0), a3, voffA);
            PG8_WAIT_V(8); PG8_WAIT_L(0); PG8_BAR; PG8_MMA(1, 0, At, B0); PG8_MMA(1, 1, At, B1); PG8_BAR; PG8_SCHED;
        }
        if (wr == 0) PG8_BAR;
        E(acc, cur, wr, wc, fr, fq);
        if (!has_next) break;
#pragma unroll
        for (int a = 0; a < 2; ++a)
#pragma unroll
            for (int b = 0; b < 2; ++b)
#pragma unroll
                for (int m = 0; m < 4; ++m)
#pragma unroll
                    for (int n = 0; n < 2; ++n) acc[a][b][m][n] = (f32x4){0.f, 0.f, 0.f, 0.f};
        cur = nxt; cA = nA; cB = nB; ++ui;
        if (wr == 1) PG8_BAR;
    }
    PG8_WAIT_V(0);
    PG8_BAR;
#undef PG8_SA
#undef PG8_SB
#undef PG8_STAGE
#undef PG8_LDA
#undef PG8_LDB
#undef PG8_MMA
#undef PG8_WAIT_V
#undef PG8_WAIT_L
#undef PG8_BAR
#undef PG8_SCHED
}
}

typedef unsigned short bf16;
typedef short bf16x8 __attribute__((ext_vector_type(8)));
typedef float f32x4 __attribute__((ext_vector_type(4)));
typedef float f32x16 __attribute__((ext_vector_type(16)));
typedef unsigned u32x4 __attribute__((ext_vector_type(4)));
typedef unsigned u32x2 __attribute__((ext_vector_type(2)));
#define LAS __attribute__((address_space(3)))

constexpr int BATCH = 2, SEQ = 8192, T = BATCH * SEQ, DM = 4096;
constexpr int NINP = 9728;
constexpr int PC_CQ = 0, PC_CKV = 768, PC_KR = 1280, PC_HQ = 1536, PC_HF = 3584, PC_HI = 5632, PC_HG = 7680;
constexpr int NQ = 3072, NKN = 2048, DFF = 11008, NUP = 2 * DFF;
constexpr float EPS = 1e-6f;
constexpr float C2 = 0.07216878364870322f * 1.4426950408889634f;
constexpr int NWAVES = 8, NTHR = 512;

constexpr size_t WS_CTL = 0;
constexpr size_t WS_WDOWN = 1u << 20;
constexpr size_t WS_WOUT = WS_WDOWN + (size_t)DM * DFF * 2;
constexpr size_t WS_WIN = WS_WOUT + (size_t)DM * DM * 2;
constexpr size_t WS_WUQ = WS_WIN + (size_t)NINP * DM * 2;
constexpr size_t WS_WKV = WS_WUQ + (size_t)NQ * 768 * 2;
constexpr size_t WS_WUP = WS_WKV + (size_t)4096 * 512 * 2;
constexpr size_t WS_H1B = WS_WUP + (size_t)NUP * DM * 2;
constexpr size_t WS_R = WS_H1B + (size_t)T * DM * 2;
constexpr size_t WS_XB = WS_R;
constexpr size_t WS_PROJ = WS_XB + (size_t)T * DM * 2;
constexpr size_t WS_Q = WS_PROJ + (size_t)T * NINP * 2;
constexpr size_t WS_KN = WS_Q + (size_t)T * NQ * 2;
constexpr size_t WS_VT = WS_KN + (size_t)T * NKN * 2;
constexpr size_t WS_KR = WS_VT + (size_t)T * 2048 * 2;
constexpr size_t WS_MIX = WS_KR + (size_t)T * 64 * 2;
constexpr size_t WS_END = WS_MIX + (size_t)T * DM * 2;
constexpr size_t WS_ACT = WS_R;
constexpr size_t WS_HALO = WS_ACT + (size_t)T * DFF * 2;
constexpr size_t WS_FIX = WS_HALO + (size_t)64 * 86 * 2 * 128 * 4;
constexpr size_t WS_H2B = WS_FIX + (size_t)64 * 86 * 4 * 128 * 4;
static_assert(WS_H2B + (size_t)T * DM * 2 <= WS_END, "act/halo/fix/h2b overlay");
constexpr int CF_SS1 = 0, CF_SSQ = 16384, CF_SSKV = 32768, CF_SS2 = 49152, CF_SS3 = 65536, CF_QCNT = 81920, CF_LBV = 82944, CF_ZERO_BEGIN = CF_SSQ, CF_ZERO_END = CF_QCNT + 64;

constexpr int LDS_BYTES = 143360;

__device__ const float INV_FREQ[32] = {1.000000000e+00f, 7.498942018e-01f, 5.623413324e-01f, 4.216965139e-01f, 3.162277639e-01f, 2.371373922e-01f, 1.778279394e-01f, 1.333521456e-01f, 1.000000015e-01f, 7.498941571e-02f, 5.623412877e-02f, 4.216964915e-02f, 3.162277862e-02f, 2.371373586e-02f, 1.778279431e-02f, 1.333521493e-02f, 9.999999776e-03f, 7.498942316e-03f, 5.623413250e-03f, 4.216964822e-03f, 3.162277862e-03f, 2.371373819e-03f, 1.778279431e-03f, 1.333521446e-03f, 1.000000047e-03f, 7.498941850e-04f, 5.623413017e-04f, 4.216965463e-04f, 3.162277862e-04f, 2.371373848e-04f, 1.778279402e-04f, 1.333521504e-04f};

struct Params {
    const float* x; const int* pos; const float* mix_g; const float* w_in; const float* qn_g; const float* w_uq; const float* kvn_g; const float* w_ukv;
    const float* attn_g; const float* lb; const float* hg_g; const float* w_out; const float* ffn_g; const float* w_up; const float* conv_w; const float* conv_b;
    const float* w_down; const float* fin_g; float* out; unsigned char* ws; int ph_lo, ph_hi;
};

__device__ __forceinline__ unsigned f2bf(float f) { unsigned u = __builtin_bit_cast(unsigned, f); return (u + 0x7fffu + ((u >> 16) & 1u)) >> 16; }
__device__ __forceinline__ unsigned pk2(float lo, float hi) { return pg8::cvt_pk_bf16(lo, hi); }
__device__ __forceinline__ float bf2f(unsigned short b) { return __builtin_bit_cast(float, (unsigned)b << 16); }
__device__ __forceinline__ float wave_sum(float v) {
#pragma unroll
    for (int o = 1; o < 64; o <<= 1) v += __shfl_xor(v, o);
    return v;
}
__device__ __forceinline__ void sincos_big(float ang, float& c, float& s) {
    const double rev = (double)ang * 0.15915494309189535; const float fr = (float)(rev - __builtin_floor(rev));
    s = __builtin_amdgcn_sinf(fr); c = __builtin_amdgcn_cosf(fr);
}

__device__ __forceinline__ void transpose_item(const float* W, int ldw, int src_col0, const float* gain, bf16* WT, int K, int dst_row0, int k0, LAS float* scr, int lane) {
    if (src_col0 >= 0) {
        float wv[32];
        const float* wp = W + (size_t)(k0 + (lane >> 5)) * ldw + src_col0 + (lane & 31);
#pragma unroll
        for (int i = 0; i < 32; ++i) wv[i] = __builtin_nontemporal_load(wp + (size_t)(2 * i) * ldw);
        if (gain) { const float* gp = gain + k0 + (lane >> 5);
#pragma unroll
            for (int i = 0; i < 32; ++i) wv[i] *= gp[2 * i]; }
#pragma unroll
        for (int i = 0; i < 32; ++i) scr[(2 * i + (lane >> 5)) * 33 + (lane & 31)] = wv[i];
    } else {
#pragma unroll 8
        for (int i = 0; i < 32; ++i) { const int kk = 2 * i + (lane >> 5); scr[kk * 33 + (lane & 31)] = 0.f; }
    }
    asm volatile("s_waitcnt lgkmcnt(0)" ::: "memory");
    const int c = lane & 7;
#pragma unroll
    for (int j = 0; j < 4; ++j) { const int n = (lane >> 3) + 8 * j; const LAS float* s = scr + (8 * c) * 33 + n;
        u32x4 o; o.x = pk2(s[0 * 33], s[1 * 33]); o.y = pk2(s[2 * 33], s[3 * 33]); o.z = pk2(s[4 * 33], s[5 * 33]); o.w = pk2(s[6 * 33], s[7 * 33]);
        *(u32x4*)(WT + (size_t)(dst_row0 + n) * K + k0 + 8 * c) = o; }
    asm volatile("s_waitcnt lgkmcnt(0)" ::: "memory");
}

constexpr int NB_IN = NINP / 32, KB_IN = DM / 64, I_IN = NB_IN * KB_IN;
constexpr int NB_UQ = NQ / 32, KB_UQ = 768 / 64, I_UQ = NB_UQ * KB_UQ;
constexpr int NB_KV = 4096 / 32, KB_KV = 512 / 64, I_KV = NB_KV * KB_KV;
constexpr int NB_OUT = DM / 32, KB_OUT = DM / 64, I_OUT = NB_OUT * KB_OUT;
constexpr int NB_UP = NUP / 32, KB_UP = DM / 64, I_UP = NB_UP * KB_UP;
constexpr int NB_DN = DM / 32, KB_DN = DFF / 64, I_DN = NB_DN * KB_DN;
constexpr int IT_EARLY = I_IN + I_UQ + I_KV;
constexpr int IT_MID = IT_EARLY + I_OUT + I_UP;
constexpr int IT_ALL = IT_MID + I_DN;
__device__ __forceinline__ void transpose_items(const Params& p, LAS unsigned char* lds, int it0, int it1, int rw, int nw) {
    const int lane = threadIdx.x & 63, wave = threadIdx.x >> 6;
    unsigned char* ws = p.ws;
    LAS float* scr = (LAS float*)(lds + wave * 16384);
    for (int it = it0 + rw; it < it1; it += nw) {
        int r = it;
        if (r < I_IN) { const int kb = r / NB_IN, nb = r % NB_IN; const int n = nb * 32; const int src = n < 1344 ? n : (n < 1536 ? -1 : n - 192);
            transpose_item(p.w_in, 9536, src, p.mix_g, (bf16*)(ws + WS_WIN), DM, n, kb * 64, scr, lane); continue; } r -= I_IN;
        if (r < I_UQ) { const int kb = r / NB_UQ, nb = r % NB_UQ; transpose_item(p.w_uq, NQ, nb * 32, p.qn_g, (bf16*)(ws + WS_WUQ), 768, nb * 32, kb * 64, scr, lane); continue; } r -= I_UQ;
        if (r < I_KV) { const int kb = r / NB_KV, nb = r % NB_KV; const int src = nb < 64 ? (nb >> 2) * 256 + (nb & 3) * 32 : ((nb - 64) >> 2) * 256 + 128 + ((nb - 64) & 3) * 32;
            transpose_item(p.w_ukv, 4096, src, p.kvn_g, (bf16*)(ws + WS_WKV), 512, nb * 32, kb * 64, scr, lane); continue; } r -= I_KV;
        if (r < I_OUT) { const int kb = r / NB_OUT, nb = r % NB_OUT; transpose_item(p.w_out, DM, nb * 32, nullptr, (bf16*)(ws + WS_WOUT), DM, nb * 32, kb * 64, scr, lane); continue; } r -= I_OUT;
        if (r < I_UP) { const int kb = r / NB_UP, nb = r % NB_UP; const int pn = nb >> 3, c0 = (nb & 7) * 32; const int src = c0 < 128 ? 128 * pn + c0 : DFF + 128 * pn + c0 - 128;
            transpose_item(p.w_up, NUP, src, p.ffn_g, (bf16*)(ws + WS_WUP), DM, nb * 32, kb * 64, scr, lane); continue; } r -= I_UP;
        { const int kb = r / NB_DN, nb = r % NB_DN; transpose_item(p.w_down, DM, nb * 32, nullptr, (bf16*)(ws + WS_WDOWN), DFF, nb * 32, kb * 64, scr, lane); }
    }
}
__device__ __forceinline__ void transpose_in_idle_round(const Params& p, LAS unsigned char* lds, int it0, int it1, int nwg, int G) {
    const int first_idle = nwg % G, c = (int)blockIdx.x, wave = threadIdx.x >> 6;
    if (first_idle == 0) transpose_items(p, lds, it0, it1, c * NWAVES + wave, G * NWAVES);
    else if (c >= first_idle) transpose_items(p, lds, it0, it1, (c - first_idle) * NWAVES + wave, (G - first_idle) * NWAVES);
}
__device__ __forceinline__ void p0_prologue(const Params& p, LAS unsigned char* lds, int G) {
    const int tid = threadIdx.x, lane = tid & 63, wave = tid >> 6;
    unsigned char* ws = p.ws; float* ctl = (float*)(ws + WS_CTL);
    const int gt = blockIdx.x * NTHR + tid, NGT = G * NTHR;
    for (int i = CF_ZERO_BEGIN + gt; i < CF_ZERO_END; i += NGT) ctl[i] = 0.f;
    for (int j = gt; j < 2048; j += NGT) ctl[CF_LBV + j] = 1.f / (1.f + __expf(p.lb[2048 + j] - p.lb[j]));
    const int gw = blockIdx.x * NWAVES + wave, NGW = G * NWAVES;
    transpose_items(p, lds, 0, IT_EARLY, gw, NGW);
    bf16* xb = (bf16*)(ws + WS_XB);
    for (int m = gw; m < T; m += NGW) {
        const f32x4* xr = (const f32x4*)(p.x + (size_t)m * DM) + lane; u32x2* o8 = (u32x2*)(xb + (size_t)m * DM) + lane; float s = 0.f;
        f32x4 xv[16];
#pragma unroll
        for (int j = 0; j < 16; ++j) xv[j] = __builtin_nontemporal_load(xr + 64 * j);
#pragma unroll
        for (int j = 0; j < 16; ++j) { const f32x4 v = xv[j]; s += (v[0] * v[0] + v[1] * v[1]) + (v[2] * v[2] + v[3] * v[3]); u32x2 w; w.x = pk2(v[0], v[1]); w.y = pk2(v[2], v[3]); o8[64 * j] = w; }
        s = wave_sum(s); if (lane == 0) ctl[CF_SS1 + m] = s;
    }
}

__device__ __forceinline__ void krope_pass(const Params& p, int G) {
    const bf16* proj = (const bf16*)(p.ws + WS_PROJ); bf16* kr = (bf16*)(p.ws + WS_KR);
    const int gt = blockIdx.x * NTHR + threadIdx.x, NGT = G * NTHR;
    for (int w = gt; w < T * 32; w += NGT) {
        const int m = w >> 5, i = w & 31;
        const float x1 = bf2f(proj[(size_t)m * NINP + PC_KR + i]), x2 = bf2f(proj[(size_t)m * NINP + PC_KR + 32 + i]);
        float c, s; sincos_big((float)p.pos[m] * INV_FREQ[i], c, s);
        kr[(size_t)m * 64 + i] = (bf16)f2bf(x1 * c - x2 * s); kr[(size_t)m * 64 + 32 + i] = (bf16)f2bf(x2 * c + x1 * s);
    }
}

constexpr int AK_STRIDE = 400, AV_STRIDE = 144, AK_BYTES = 64 * AK_STRIDE, AV_BYTES = 128 * AV_STRIDE;
constexpr int A_KOFF = 0, A_VOFF = 2 * AK_BYTES, ATTN_LDS = 2 * AK_BYTES + 2 * AV_BYTES;
__device__ __forceinline__ int kperm(int r) { return (r & ~12) | ((r & 4) << 1) | ((r & 8) >> 1); }

__device__ __forceinline__ void attn_unit(const Params& p, int b, int h, int qb, unsigned char* lds) {
    const int tid = threadIdx.x, lane = tid & 63, r32 = lane & 31, hi = lane >> 5, wid = __builtin_amdgcn_readfirstlane(tid >> 6);
    const bf16* qg = (const bf16*)(p.ws + WS_Q); const bf16* kn = (const bf16*)(p.ws + WS_KN); const bf16* kr = (const bf16*)(p.ws + WS_KR); const bf16* vt = (const bf16*)(p.ws + WS_VT);
    bf16* mix = (bf16*)(p.ws + WS_MIX);
    const int rowbase = b * SEQ, q0 = qb * 256;
    const int qrow = rowbase + q0 + wid * 32 + r32, qpos = q0 + wid * 32 + r32;
    const bf16* ksrc[3]; int kdst[3]; size_t kstep[3];
#pragma unroll
    for (int i = 0; i < 3; ++i) { const int pc = tid + 512 * i, rho = pc / 24, c = pc % 24, key = (rho & ~31) + kperm(rho & 31);
        if (c < 16) { ksrc[i] = kn + (size_t)(rowbase + key) * NKN + h * 128 + c * 8; kstep[i] = (size_t)64 * NKN; }
        else { ksrc[i] = kr + (size_t)(rowbase + key) * 64 + (c - 16) * 8; kstep[i] = (size_t)64 * 64; }
        kdst[i] = rho * AK_STRIDE + c * 16; }
    const bf16* vsrc[2]; int vdst[2];
#pragma unroll
    for (int i = 0; i < 2; ++i) { const int pc = tid + 512 * i, d = pc >> 3, c = pc & 7; vsrc[i] = vt + (size_t)(h * 128 + d) * T + rowbase + c * 8; vdst[i] = d * AV_STRIDE + c * 16; }
    const int NT = (q0 + 256) / 64;
    u32x4 kreg[3], vreg[2];
#pragma unroll
    for (int i = 0; i < 3; ++i) kreg[i] = *(const u32x4*)(ksrc[i]);
#pragma unroll
    for (int i = 0; i < 2; ++i) vreg[i] = *(const u32x4*)(vsrc[i]);
    bf16x8 qf[12];
    { const bf16* qp = qg + (size_t)qrow * NQ + h * 192 + 8 * hi;
#pragma unroll
      for (int d0 = 0; d0 < 12; ++d0) qf[d0] = *(const bf16x8*)(qp + 16 * d0);
      const float fpos = (float)p.pos[qrow];
#pragma unroll
      for (int jj = 0; jj < 2; ++jj)
#pragma unroll
          for (int j = 0; j < 8; ++j) { const int i = 16 * jj + 8 * hi + j; float c, s; sincos_big(fpos * INV_FREQ[i], c, s);
              const float x1 = bf2f((unsigned short)qf[8 + jj][j]), x2 = bf2f((unsigned short)qf[10 + jj][j]);
              qf[8 + jj][j] = (short)f2bf(x1 * c - x2 * s); qf[10 + jj][j] = (short)f2bf(x2 * c + x1 * s); }
    }
#pragma unroll
    for (int i = 0; i < 3; ++i) *(u32x4*)(lds + A_KOFF + kdst[i]) = kreg[i];
#pragma unroll
    for (int i = 0; i < 2; ++i) *(u32x4*)(lds + A_VOFF + vdst[i]) = vreg[i];
    __syncthreads();
    f32x16 o[4];
#pragma unroll
    for (int d = 0; d < 4; ++d)
#pragma unroll
        for (int r = 0; r < 16; ++r) o[d][r] = 0.f;
    float m_run = -INFINITY, l_run = 0.f;
    const int wave_last = q0 + wid * 32 + 31;
    for (int t = 0; t < NT; ++t) {
        const int kv0 = 64 * t, buf = t & 1;
        if (t + 1 < NT) {
#pragma unroll
            for (int i = 0; i < 3; ++i) kreg[i] = *(const u32x4*)(ksrc[i] + (size_t)(t + 1) * kstep[i]);
#pragma unroll
            for (int i = 0; i < 2; ++i) vreg[i] = *(const u32x4*)(vsrc[i] + (size_t)(t + 1) * 64);
        }
        if (kv0 <= wave_last) {
            const unsigned char* Kb = lds + A_KOFF + buf * AK_BYTES + r32 * AK_STRIDE + hi * 16;
            const unsigned char* Vb = lds + A_VOFF + buf * AV_BYTES + r32 * AV_STRIDE + hi * 16;
            f32x16 s0, s1;
#pragma unroll
            for (int r = 0; r < 16; ++r) { s0[r] = 0.f; s1[r] = 0.f; }
            const unsigned char* Kb1 = Kb + 32 * AK_STRIDE;
            bf16x8 ka0 = *(const bf16x8*)(Kb), kb0 = *(const bf16x8*)(Kb1), ka1 = *(const bf16x8*)(Kb + 32), kb1 = *(const bf16x8*)(Kb1 + 32), ka2 = *(const bf16x8*)(Kb + 64), kb2 = *(const bf16x8*)(Kb1 + 64);
            __builtin_amdgcn_s_setprio(1);
#pragma unroll
            for (int d0 = 0; d0 < 12; d0 += 3) {
                s0 = __builtin_amdgcn_mfma_f32_32x32x16_bf16(ka0, qf[d0], s0, 0, 0, 0);
                s1 = __builtin_amdgcn_mfma_f32_32x32x16_bf16(kb0, qf[d0], s1, 0, 0, 0);
                if (d0 + 3 < 12) { ka0 = *(const bf16x8*)(Kb + (d0 + 3) * 32); kb0 = *(const bf16x8*)(Kb1 + (d0 + 3) * 32); }
                __builtin_amdgcn_sched_barrier(0);
                s0 = __builtin_amdgcn_mfma_f32_32x32x16_bf16(ka1, qf[d0 + 1], s0, 0, 0, 0);
                s1 = __builtin_amdgcn_mfma_f32_32x32x16_bf16(kb1, qf[d0 + 1], s1, 0, 0, 0);
                if (d0 + 4 < 12) { ka1 = *(const bf16x8*)(Kb + (d0 + 4) * 32); kb1 = *(const bf16x8*)(Kb1 + (d0 + 4) * 32); }
                __builtin_amdgcn_sched_barrier(0);
                s0 = __builtin_amdgcn_mfma_f32_32x32x16_bf16(ka2, qf[d0 + 2], s0, 0, 0, 0);
                s1 = __builtin_amdgcn_mfma_f32_32x32x16_bf16(kb2, qf[d0 + 2], s1, 0, 0, 0);
                if (d0 + 5 < 12) { ka2 = *(const bf16x8*)(Kb + (d0 + 5) * 32); kb2 = *(const bf16x8*)(Kb1 + (d0 + 5) * 32); }
                __builtin_amdgcn_sched_barrier(0);
            }
            __builtin_amdgcn_s_setprio(0);
            if (kv0 + 63 > q0 + wid * 32) {
#pragma unroll
                for (int r = 0; r < 16; ++r) { const int key = kv0 + 16 * (r >> 3) + 8 * hi + (r & 7);
                    if (key > qpos) s0[r] = -INFINITY; if (key + 32 > qpos) s1[r] = -INFINITY; }
            }
            float mx = fmaxf(s0[0], s1[0]);
#pragma unroll
            for (int r = 1; r < 16; ++r) mx = fmaxf(mx, fmaxf(s0[r], s1[r]));
            mx = fmaxf(mx, __shfl_xor(mx, 32));
            if (__any(mx > m_run + 8.f)) {
                const float m_new = fmaxf(m_run, mx), alpha = __builtin_amdgcn_exp2f(m_run - m_new); m_run = m_new;
                l_run *= alpha;
#pragma unroll
                for (int d = 0; d < 4; ++d)
#pragma unroll
                    for (int r = 0; r < 16; ++r) o[d][r] *= alpha;
            }
            float sum = 0.f;
#pragma unroll
            for (int r = 0; r < 16; ++r) { s0[r] = __builtin_amdgcn_exp2f(s0[r] - m_run); s1[r] = __builtin_amdgcn_exp2f(s1[r] - m_run); sum += s0[r] + s1[r]; }
            l_run += sum;
            bf16x8 pb[2][2];
#pragma unroll
            for (int ks = 0; ks < 2; ++ks) {
                u32x4 w0, w1;
                w0.x = pk2(s0[8 * ks + 0], s0[8 * ks + 1]); w0.y = pk2(s0[8 * ks + 2], s0[8 * ks + 3]); w0.z = pk2(s0[8 * ks + 4], s0[8 * ks + 5]); w0.w = pk2(s0[8 * ks + 6], s0[8 * ks + 7]);
                w1.x = pk2(s1[8 * ks + 0], s1[8 * ks + 1]); w1.y = pk2(s1[8 * ks + 2], s1[8 * ks + 3]); w1.z = pk2(s1[8 * ks + 4], s1[8 * ks + 5]); w1.w = pk2(s1[8 * ks + 6], s1[8 * ks + 7]);
                pb[0][ks] = __builtin_bit_cast(bf16x8, w0); pb[1][ks] = __builtin_bit_cast(bf16x8, w1);
            }
            bf16x8 va[4];
#pragma unroll
            for (int i = 0; i < 4; ++i) va[i] = *(const bf16x8*)(Vb + (i >> 2) * 32 * AV_STRIDE + (i & 3) * 32);
            __builtin_amdgcn_s_setprio(1);
#pragma unroll
            for (int i = 0; i < 16; ++i) {
                o[i >> 2] = __builtin_amdgcn_mfma_f32_32x32x16_bf16(va[i & 3], pb[(i >> 1) & 1][i & 1], o[i >> 2], 0, 0, 0);
                if (i + 4 < 16) va[i & 3] = *(const bf16x8*)(Vb + ((i + 4) >> 2) * 32 * AV_STRIDE + ((i + 4) & 3) * 32);
                __builtin_amdgcn_sched_barrier(0);
            }
            __builtin_amdgcn_s_setprio(0);
        }
        if (t + 1 < NT) {
            const int nb = buf ^ 1;
#pragma unroll
            for (int i = 0; i < 3; ++i) *(u32x4*)(lds + A_KOFF + nb * AK_BYTES + kdst[i]) = kreg[i];
#pragma unroll
            for (int i = 0; i < 2; ++i) *(u32x4*)(lds + A_VOFF + nb * AV_BYTES + vdst[i]) = vreg[i];
        }
        __syncthreads();
    }
    const float l_tot = l_run + __shfl_xor(l_run, 32), il = 1.f / l_tot;
    float ss = 0.f;
#pragma unroll
    for (int d = 0; d < 4; ++d)
#pragma unroll
        for (int r = 0; r < 16; ++r) { o[d][r] *= il; ss += o[d][r] * o[d][r]; }
    ss += __shfl_xor(ss, 32);
    const float rstd = __builtin_amdgcn_rsqf(ss * (1.f / 128.f) + EPS);
    bf16* op = mix + (size_t)qrow * DM + h * 128;
    const float* gp = p.attn_g + h * 128;
#pragma unroll
    for (int d = 0; d < 4; ++d)
#pragma unroll
        for (int g4 = 0; g4 < 4; ++g4) { const int dd = d * 32 + 8 * g4 + 4 * hi; const f32x4 gv = *(const f32x4*)(gp + dd);
            u32x2 w; w.x = pk2(o[d][4 * g4 + 0] * rstd * gv[0], o[d][4 * g4 + 1] * rstd * gv[1]); w.y = pk2(o[d][4 * g4 + 2] * rstd * gv[2], o[d][4 * g4 + 3] * rstd * gv[3]);
            *(u32x2*)(op + dd) = w; }
}

constexpr int H_QS = 136 * 2, H_TS = 72 * 2, H_OS = 132 * 4;
constexpr int H_QT = 0, H_KH = H_QT + 64 * H_QS, H_KB = H_KH + 64 * H_QS, H_VT = H_KB + 128 * H_TS, H_A = H_VT + 128 * H_TS, H_ST = H_A + 64 * H_TS,
              H_SEG = H_ST + 128 * H_QS, H_DEC = H_SEG + 4 * 128 * 4, H_END = H_DEC + 128 * 4, H_O = H_QT;
static_assert(64 * H_OS <= 2 * 64 * H_QS, "o overlay");
static_assert(H_END <= LDS_BYTES, "hgrn lds");

__device__ __forceinline__ void hgrn_stream(const Params& p, int b, int h, unsigned char* lds) {
    const int tid = threadIdx.x, lane = tid & 63, r32 = lane & 31, hi = lane >> 5, wid = __builtin_amdgcn_readfirstlane(tid >> 6);
    const bf16* proj = (const bf16*)(p.ws + WS_PROJ); bf16* mix = (bf16*)(p.ws + WS_MIX);
    const float* ctl = (const float*)(p.ws + WS_CTL);
    const int c = tid & 127, seg = tid >> 7;
    const float lbv = ctl[CF_LBV + h * 128 + c], oml = 1.f - lbv;
    const int db = wid >> 1, eb0 = 2 * (wid & 1);
    f32x16 S0, S1;
#pragma unroll
    for (int r = 0; r < 16; ++r) { S0[r] = 0.f; S1[r] = 0.f; }
    for (int i = tid; i < 128 * H_QS / 4; i += NTHR) ((unsigned*)(lds + H_ST))[i] = 0u;
    const int tb = wid >> 2, eb = wid & 3;
    __syncthreads();
    unsigned short zr[16], qr[16], vr[16];
    { const bf16* pf = proj + ((size_t)b * SEQ + 16 * seg) * NINP + h * 128 + c;
#pragma unroll
      for (int i = 0; i < 16; ++i) { zr[i] = pf[(size_t)i * NINP + PC_HF]; qr[i] = pf[(size_t)i * NINP + PC_HQ]; vr[i] = pf[(size_t)i * NINP + PC_HI]; } }
    for (int ch = 0; ch < SEQ / 64; ++ch) {
        const size_t row0 = (size_t)b * SEQ + (size_t)ch * 64;
        float G[16], kk[16];
        float run = 0.f;
#pragma unroll
        for (int i = 0; i < 16; ++i) { const float z = bf2f(zr[i]); const float ez = __expf(-z); const float sig = __builtin_amdgcn_rcpf(1.f + ez);
            const float f = lbv + oml * sig; run += __builtin_amdgcn_logf(f) * 0.6931471805599453f; G[i] = run; kk[i] = oml * ez * sig; }
        ((float*)(lds + H_SEG))[seg * 128 + c] = run;
        float qv[16], vv[16];
#pragma unroll
        for (int i = 0; i < 16; ++i) { qv[i] = bf2f(qr[i]); vv[i] = bf2f(vr[i]); }
        __syncthreads();
        float pre = 0.f, tot = 0.f;
#pragma unroll
        for (int s = 0; s < 4; ++s) { const float v = ((const float*)(lds + H_SEG))[s * 128 + c]; tot += v; if (s < seg) pre += v; }
        if (seg == 0) ((float*)(lds + H_DEC))[c] = __expf(tot);
        unsigned kbw[8], vtw[8];
#pragma unroll
        for (int i = 0; i < 16; i += 2) {
            const float g0 = G[i] + pre, g1 = G[i + 1] + pre;
            const float e0 = __expf(g0), e1 = __expf(g1);
            const int t0 = 16 * seg + i;
            *(bf16*)(lds + H_QT + t0 * H_QS + c * 2) = (bf16)f2bf(qv[i] * 0.08838834764831845f * e0);
            *(bf16*)(lds + H_QT + (t0 + 1) * H_QS + c * 2) = (bf16)f2bf(qv[i + 1] * 0.08838834764831845f * e1);
            *(bf16*)(lds + H_KH + t0 * H_QS + c * 2) = (bf16)f2bf(kk[i] * __expf(-g0));
            *(bf16*)(lds + H_KH + (t0 + 1) * H_QS + c * 2) = (bf16)f2bf(kk[i + 1] * __expf(-g1));
            kbw[i >> 1] = pk2(kk[i] * __expf(tot - g0), kk[i + 1] * __expf(tot - g1));
            vtw[i >> 1] = pk2(vv[i], vv[i + 1]);
        }
        *(u32x4*)(lds + H_KB + c * H_TS + seg * 32) = (u32x4){kbw[0], kbw[1], kbw[2], kbw[3]};
        *(u32x4*)(lds + H_KB + c * H_TS + seg * 32 + 16) = (u32x4){kbw[4], kbw[5], kbw[6], kbw[7]};
        *(u32x4*)(lds + H_VT + c * H_TS + seg * 32) = (u32x4){vtw[0], vtw[1], vtw[2], vtw[3]};
        *(u32x4*)(lds + H_VT + c * H_TS + seg * 32 + 16) = (u32x4){vtw[4], vtw[5], vtw[6], vtw[7]};
        if (ch + 1 < SEQ / 64) { const bf16* pf = proj + (row0 + 64 + 16 * seg) * NINP + h * 128 + c;
#pragma unroll
            for (int i = 0; i < 16; ++i) { zr[i] = pf[(size_t)i * NINP + PC_HF]; qr[i] = pf[(size_t)i * NINP + PC_HQ]; vr[i] = pf[(size_t)i * NINP + PC_HI]; } }
        __syncthreads();
        if (wid < 3) {
            const int atb = wid == 0 ? 0 : 1, asb = wid == 2 ? 1 : 0;
            f32x16 a;
#pragma unroll
            for (int r = 0; r < 16; ++r) a[r] = 0.f;
#pragma unroll
            for (int k8 = 0; k8 < 8; ++k8) {
                const bf16x8 x = *(const bf16x8*)(lds + H_QT + (atb * 32 + r32) * H_QS + (16 * k8 + 8 * hi) * 2);
                const bf16x8 y = *(const bf16x8*)(lds + H_KH + (asb * 32 + r32) * H_QS + (16 * k8 + 8 * hi) * 2);
                a = __builtin_amdgcn_mfma_f32_32x32x16_bf16(x, y, a, 0, 0, 0);
            }
            const int s = asb * 32 + r32;
#pragma unroll
            for (int r = 0; r < 16; ++r) { const int t = atb * 32 + (r & 3) + 8 * (r >> 2) + 4 * hi;
                *(bf16*)(lds + H_A + t * H_TS + s * 2) = (bf16)(s <= t ? f2bf(a[r]) : 0u); }
        }
        f32x16 oacc;
#pragma unroll
        for (int r = 0; r < 16; ++r) oacc[r] = 0.f;
#pragma unroll
        for (int k8 = 0; k8 < 8; ++k8) {
            const bf16x8 x = *(const bf16x8*)(lds + H_QT + (tb * 32 + r32) * H_QS + (16 * k8 + 8 * hi) * 2);
            const bf16x8 y = *(const bf16x8*)(lds + H_ST + (eb * 32 + r32) * H_QS + (16 * k8 + 8 * hi) * 2);
            oacc = __builtin_amdgcn_mfma_f32_32x32x16_bf16(x, y, oacc, 0, 0, 0);
        }
        {
            const float* dec = (const float*)(lds + H_DEC) + db * 32 + 4 * hi;
#pragma unroll
            for (int g4 = 0; g4 < 4; ++g4) { const f32x4 dv = *(const f32x4*)(dec + 8 * g4);
#pragma unroll
                for (int j = 0; j < 4; ++j) { S0[4 * g4 + j] *= dv[j]; S1[4 * g4 + j] *= dv[j]; } }
#pragma unroll
            for (int k4 = 0; k4 < 4; ++k4) {
                const bf16x8 x = *(const bf16x8*)(lds + H_KB + (db * 32 + r32) * H_TS + (16 * k4 + 8 * hi) * 2);
                const bf16x8 y0 = *(const bf16x8*)(lds + H_VT + (eb0 * 32 + r32) * H_TS + (16 * k4 + 8 * hi) * 2);
                const bf16x8 y1 = *(const bf16x8*)(lds + H_VT + ((eb0 + 1) * 32 + r32) * H_TS + (16 * k4 + 8 * hi) * 2);
                S0 = __builtin_amdgcn_mfma_f32_32x32x16_bf16(x, y0, S0, 0, 0, 0);
                S1 = __builtin_amdgcn_mfma_f32_32x32x16_bf16(x, y1, S1, 0, 0, 0);
            }
        }
        __syncthreads();
        {
            const int nk = tb == 0 ? 2 : 4;
            for (int k4 = 0; k4 < nk; ++k4) {
                const bf16x8 x = *(const bf16x8*)(lds + H_A + (tb * 32 + r32) * H_TS + (16 * k4 + 8 * hi) * 2);
                const bf16x8 y = *(const bf16x8*)(lds + H_VT + (eb * 32 + r32) * H_TS + (16 * k4 + 8 * hi) * 2);
                oacc = __builtin_amdgcn_mfma_f32_32x32x16_bf16(x, y, oacc, 0, 0, 0);
            }
#pragma unroll
            for (int r = 0; r < 16; ++r) { const int t = tb * 32 + (r & 3) + 8 * (r >> 2) + 4 * hi; *(float*)(lds + H_O + t * H_OS + (eb * 32 + r32) * 4) = oacc[r]; }
#pragma unroll
            for (int g4 = 0; g4 < 4; ++g4) {
                const int d = db * 32 + 8 * g4 + 4 * hi;
                u32x2 w0, w1; w0.x = pk2(S0[4 * g4], S0[4 * g4 + 1]); w0.y = pk2(S0[4 * g4 + 2], S0[4 * g4 + 3]); w1.x = pk2(S1[4 * g4], S1[4 * g4 + 1]); w1.y = pk2(S1[4 * g4 + 2], S1[4 * g4 + 3]);
                *(u32x2*)(lds + H_ST + (eb0 * 32 + r32) * H_QS + d * 2) = w0;
                *(u32x2*)(lds + H_ST + ((eb0 + 1) * 32 + r32) * H_QS + d * 2) = w1;
            }
        }
        __syncthreads();
        {
            const int t = tid >> 3, e0 = (tid & 7) * 16;
            const float* orow = (const float*)(lds + H_O + t * H_OS) + e0;
            f32x4 ov[4]; float ss = 0.f;
#pragma unroll
            for (int j = 0; j < 4; ++j) { ov[j] = *(const f32x4*)(orow + 4 * j); ss += (ov[j][0] * ov[j][0] + ov[j][1] * ov[j][1]) + (ov[j][2] * ov[j][2] + ov[j][3] * ov[j][3]); }
            ss += __shfl_xor(ss, 1); ss += __shfl_xor(ss, 2); ss += __shfl_xor(ss, 4);
            const float rstd = __builtin_amdgcn_rsqf(ss * (1.f / 128.f) + EPS);
            const bf16* gp = proj + (row0 + t) * NINP + PC_HG + h * 128 + e0;
            const u32x4 gw0 = *(const u32x4*)gp, gw1 = *(const u32x4*)(gp + 8);
            const float* ng = p.hg_g + h * 128 + e0;
            float res[16];
#pragma unroll
            for (int j = 0; j < 16; ++j) { const unsigned wv = j < 8 ? gw0[j >> 1] : gw1[(j - 8) >> 1]; const float gz = bf2f((unsigned short)((j & 1) ? (wv >> 16) : (wv & 0xffffu)));
                const float sl = gz * __builtin_amdgcn_rcpf(1.f + __expf(-gz)); res[j] = ov[j >> 2][j & 3] * rstd * ng[j] * sl; }
            bf16* op = mix + (row0 + t) * DM + 2048 + h * 128 + e0;
            *(u32x4*)op = (u32x4){pk2(res[0], res[1]), pk2(res[2], res[3]), pk2(res[4], res[5]), pk2(res[6], res[7])};
            *(u32x4*)(op + 8) = (u32x4){pk2(res[8], res[9]), pk2(res[10], res[11]), pk2(res[12], res[13]), pk2(res[14], res[15])};
        }
        __syncthreads();
    }
}

__device__ __forceinline__ void convfix_pass(const Params& p, int G) {
    const float* halo = (const float*)(p.ws + WS_HALO); const float* fixb = (const float*)(p.ws + WS_FIX); bf16* act = (bf16*)(p.ws + WS_ACT);
    const int gt = blockIdx.x * NTHR + threadIdx.x, NGT = G * NTHR;
    for (int w = gt; w < 64 * 86 * 2 * 128; w += NGT) {
        const int c = w & 127, i = (w >> 7) & 1, tile = w >> 8, pn = tile % 86, pm = tile / 86, ch = pn * 128 + c, t = pm * 256 + i;
        const float cpart = fixb[((size_t)tile * 2 + i) * 256 + c], up = fixb[((size_t)tile * 2 + i) * 256 + 128 + c];
        float h0 = 0.f, h1 = 0.f;
        if ((pm & 31) != 0) { const size_t hb = ((size_t)((pm - 1) * 86 + pn) * 2) * 128 + c; h0 = halo[hb]; h1 = halo[hb + 128]; }
        const float w0 = p.conv_w[ch], w1 = p.conv_w[DFF + ch];
        const float cv = cpart + (i == 0 ? w0 * h0 + w1 * h1 : w0 * h1);
        act[(size_t)t * DFF + ch] = (bf16)f2bf(cv / (1.f + __expf(-cv)) * up);
    }
}

__device__ __forceinline__ void final_pass(const Params& p, int G) {
    const float* ctl = (const float*)(p.ws + WS_CTL); const bf16* h2b = (const bf16*)(p.ws + WS_H2B);
    const int lane = threadIdx.x & 63, gw = blockIdx.x * NWAVES + (threadIdx.x >> 6), NGW = G * NWAVES;
    for (int m = gw; m < T; m += NGW) {
        const float rstd = __builtin_amdgcn_rsqf(ctl[CF_SS3 + m] * (1.f / DM) + EPS);
        const u32x4* hr = (const u32x4*)(h2b + (size_t)m * DM) + lane; f32x4* xr = (f32x4*)(p.out + (size_t)m * DM) + 2 * lane; const f32x4* gr = (const f32x4*)p.fin_g + 2 * lane;
        u32x4 hv[8];
#pragma unroll
        for (int j = 0; j < 8; ++j) hv[j] = hr[64 * j];
#pragma unroll
        for (int j = 0; j < 8; ++j) { const u32x4 w = hv[j]; const f32x4 g0 = gr[128 * j], g1 = gr[128 * j + 1];
            const f32x4 v0 = (f32x4){__builtin_bit_cast(float, w.x << 16), __builtin_bit_cast(float, w.x & 0xffff0000u), __builtin_bit_cast(float, w.y << 16), __builtin_bit_cast(float, w.y & 0xffff0000u)};
            const f32x4 v1 = (f32x4){__builtin_bit_cast(float, w.z << 16), __builtin_bit_cast(float, w.z & 0xffff0000u), __builtin_bit_cast(float, w.w << 16), __builtin_bit_cast(float, w.w & 0xffff0000u)};
            __builtin_nontemporal_store(v0 * rstd * g0, xr + 128 * j); __builtin_nontemporal_store(v1 * rstd * g1, xr + 128 * j + 1); }
    }
}

#define XB_TMO      128
#define XB_XCNT(j)  (256  + 64 * (j))
#define XB_XSUB(j)  (1280 + 64 * (j))
#define XB_XGEN(j)  (2304 + 64 * (j))
#define XB_TOP      3328
#define XB_TOPGEN   3392
#define XCD_BAR_WORDS 3456
#define XB_SPIN_CAP (1u << 18)
__device__ __forceinline__ unsigned xb_ld(unsigned* p)              { return __hip_atomic_load(p, __ATOMIC_RELAXED, __HIP_MEMORY_SCOPE_AGENT); }
__device__ __forceinline__ unsigned xb_add(unsigned* p, unsigned v) { return __hip_atomic_fetch_add(p, v, __ATOMIC_RELAXED, __HIP_MEMORY_SCOPE_AGENT); }
__device__ __forceinline__ unsigned xb_xcc_id() { return (unsigned)__builtin_amdgcn_s_getreg((3 << 11) | 20) & 0xFu; }
#define XB_SPIN(cond, bar) do { unsigned _sp = 0; while (cond) { __builtin_amdgcn_s_sleep(1); \
    if ((++_sp & 255u) == 0u) { if (xb_ld(&(bar)[XB_TMO])) break; if (_sp > XB_SPIN_CAP) { atomicAdd(&(bar)[XB_TMO], 1u); break; } } } } while (0)
struct XcdBarrier { unsigned* bar; unsigned x; volatile LAS unsigned* st; };
__device__ __forceinline__ XcdBarrier xcd_barrier_post(unsigned* bar, volatile LAS unsigned* st) {
    XcdBarrier b; b.bar = bar; b.x = xb_xcc_id(); b.st = st;
    if (threadIdx.x == 0) (void)xb_add(&bar[XB_XCNT(b.x)], 1u);
    return b;
}
__device__ __forceinline__ void xcd_barrier_complete(unsigned* bar, unsigned x, unsigned& nloc, unsigned& nx) {
    const unsigned G = gridDim.x * gridDim.y * gridDim.z;
    unsigned sum, cnt, mine, sp = 0u;
    for (;;) {
        sum = 0u; cnt = 0u; mine = 0u;
#pragma unroll
        for (unsigned j = 0; j < 16; ++j) { const unsigned c = xb_ld(&bar[XB_XCNT(j)]); sum += c; cnt += (c > 0u) ? 1u : 0u; mine = (j == x) ? c : mine; }
        if (sum == G) break;
        __builtin_amdgcn_s_sleep(1);
        if ((++sp & 255u) == 0u) { if (xb_ld(&bar[XB_TMO])) break; if (sp > XB_SPIN_CAP) { atomicAdd(&bar[XB_TMO], 1u); break; } }
    }
    nloc = mine > 0u ? mine : 1u; nx = cnt > 0u ? cnt : 1u;
}
__device__ __forceinline__ void xcd_barrier(const XcdBarrier& b) {
    asm volatile("s_waitcnt vmcnt(0)" ::: "memory");
    __syncthreads();
    if (threadIdx.x == 0) {
        unsigned* bar = b.bar;
        __builtin_amdgcn_s_waitcnt(0);
        unsigned nloc = b.st[0], nx = b.st[1];
        if (nloc == 0u) { xcd_barrier_complete(bar, b.x, nloc, nx); b.st[0] = nloc; b.st[1] = nx; }
        const unsigned old = xb_add(&bar[XB_XSUB(b.x)], 1u);
        const unsigned gen = old / nloc;
        if (old + 1u == (gen + 1u) * nloc) {
            __builtin_amdgcn_fence(__ATOMIC_RELEASE, "agent");
            asm volatile("s_waitcnt vmcnt(0)" ::: "memory");
            const unsigned og = xb_add(&bar[XB_TOP], 1u);
            const unsigned tg = og / nx;
            if (og + 1u == (tg + 1u) * nx) xb_add(&bar[XB_TOPGEN], 1u);
            else XB_SPIN(xb_ld(&bar[XB_TOPGEN]) == tg, bar);
            __builtin_amdgcn_fence(__ATOMIC_ACQUIRE, "agent");
            xb_add(&bar[XB_XGEN(b.x)], 1u);
            asm volatile("s_waitcnt vmcnt(0)" ::: "memory");
        } else {
            XB_SPIN(xb_ld(&bar[XB_XGEN(b.x)]) == gen, bar);
            __builtin_amdgcn_fence(__ATOMIC_ACQUIRE, "agent");
            asm volatile("s_waitcnt vmcnt(0)" ::: "memory");
        }
    }
    __syncthreads();
}
constexpr size_t WS_BAR = 524288;

__global__ void __launch_bounds__(NTHR, 2) fwd_kernel(Params p) {
    extern __shared__ __attribute__((aligned(16))) unsigned char lds[];
    LAS unsigned char* ldsl = (LAS unsigned char*)lds;
    const int G = gridDim.x;
    unsigned char* ws = p.ws; float* ctl = (float*)(ws + WS_CTL);
    const int lo = p.ph_lo, hi = p.ph_hi;
#if ONE_LAUNCH
    volatile LAS unsigned* xst = (volatile LAS unsigned*)(ldsl + LDS_BYTES - 32);
    if (threadIdx.x < 2) xst[threadIdx.x] = 0u;
    __syncthreads();
    const XcdBarrier xbar = xcd_barrier_post((unsigned*)(ws + WS_BAR), xst);
#endif
#define IN(k) (lo <= (k) && (k) < hi)
#if ONE_LAUNCH
#define SEAM(k) do { if (IN(k) && IN((k) + 1)) { if (lo < 0) { __threadfence(); cg::this_grid().sync(); __threadfence(); } xcd_barrier(xbar); } } while (0)
#else
#define SEAM(k) do { } while (0)
#endif
    if (IN(0)) { p0_prologue(p, ldsl, G); }
    SEAM(0);
    if (IN(1)) {
        pg8::Gemm g{(const bf16*)(ws + WS_XB), (const bf16*)(ws + WS_WIN), T, NINP, DM, DM, DM}; pg8::StaticOrder S; S.init(T, NINP, G, (int)blockIdx.x);
        pg8::EpiScaleBf16<false, true> E{(bf16*)(ws + WS_PROJ), NINP, ctl + CF_SS1, 1.f / DM, EPS, 1.f, ctl + CF_SSQ, ctl + CF_SSKV};
        pg8::gemm_phase(ldsl, g, S, E);
        transpose_in_idle_round(p, ldsl, IT_EARLY, IT_MID, (T / 256) * (NINP / 256), G);
    }
    SEAM(1);
    if (IN(2)) {
        { pg8::Gemm g{(const bf16*)(ws + WS_PROJ) + PC_CQ, (const bf16*)(ws + WS_WUQ), T, NQ, 768, NINP, 768}; pg8::StaticOrder S; S.init(T, NQ, G, (int)blockIdx.x);
          pg8::EpiScaleBf16<false, false> E{(bf16*)(ws + WS_Q), NQ, ctl + CF_SSQ, 1.f / 768.f, EPS, C2, nullptr, nullptr};
          pg8::gemm_phase(ldsl, g, S, E); }
        { pg8::Gemm g{(const bf16*)(ws + WS_PROJ) + PC_CKV, (const bf16*)(ws + WS_WKV), T, NKN, 512, NINP, 512}; pg8::StaticOrder S; S.init(T, NKN, G, (int)blockIdx.x);
          pg8::EpiScaleBf16<false, false> E{(bf16*)(ws + WS_KN), NKN, ctl + CF_SSKV, 1.f / 512.f, EPS, 1.f, nullptr, nullptr};
          pg8::gemm_phase(ldsl, g, S, E); }
        { pg8::Gemm g{(const bf16*)(ws + WS_WKV) + (size_t)2048 * 512, (const bf16*)(ws + WS_PROJ) + PC_CKV, 2048, T, 512, 512, NINP}; pg8::StaticOrder S; S.init(2048, T, G, (int)blockIdx.x);
          pg8::EpiScaleBf16<true, false> E{(bf16*)(ws + WS_VT), T, ctl + CF_SSKV, 1.f / 512.f, EPS, 1.f, nullptr, nullptr};
          pg8::gemm_phase(ldsl, g, S, E); }
        krope_pass(p, G);
    }
    SEAM(2);
    if (IN(3)) {
        if (blockIdx.x < 32 || G < 32) { for (int s = blockIdx.x; s < 32; s += G) hgrn_stream(p, s >> 4, s & 15, lds); }
        unsigned* qc = (unsigned*)(ctl + CF_QCNT);
        LAS unsigned* slot = (LAS unsigned*)(ldsl + LDS_BYTES - 16);
        for (;;) {
            if (threadIdx.x == 0) *slot = atomicAdd(qc, 1u);
            __syncthreads();
            const unsigned u = *slot;
            __syncthreads();
            if (u >= 1024u) break;
            const int qb = 31 - (int)(u >> 5), bh = (int)(u & 31);
            attn_unit(p, bh >> 4, bh & 15, qb, lds);
        }
    }
    SEAM(3);
    if (IN(4)) {
        pg8::Gemm g{(const bf16*)(ws + WS_MIX), (const bf16*)(ws + WS_WOUT), T, DM, DM, DM, DM}; pg8::StaticOrder S; S.init(T, DM, G, (int)blockIdx.x);
        pg8::EpiRes<0> E{nullptr, (const bf16*)(ws + WS_XB), nullptr, (bf16*)(ws + WS_H1B), DM, ctl + CF_SS2};
        pg8::gemm_phase(ldsl, g, S, E);
    }
    SEAM(4);
    if (IN(5)) {
        pg8::Gemm g{(const bf16*)(ws + WS_H1B), (const bf16*)(ws + WS_WUP), T, NUP, DM, DM, DM}; pg8::StaticOrder S; S.init(T, NUP, G, (int)blockIdx.x);
        pg8::EpiConvGlu E{(bf16*)(ws + WS_ACT), DFF, ctl + CF_SS2, 1.f / DM, EPS, p.conv_w, p.conv_b, DFF, (float*)(ws + WS_HALO), (float*)(ws + WS_FIX), (LAS float*)(ldsl + 131072), NUP / 256};
        pg8::gemm_phase(ldsl, g, S, E);
        transpose_in_idle_round(p, ldsl, IT_MID, IT_ALL, (T / 256) * (NUP / 256), G);
    }
    SEAM(5);
    if (IN(6)) { convfix_pass(p, G); }
    SEAM(6);
    if (IN(7)) {
        pg8::Gemm g{(const bf16*)(ws + WS_ACT), (const bf16*)(ws + WS_WDOWN), T, DM, DFF, DFF, DFF}; pg8::StaticOrder S; S.init(T, DM, G, (int)blockIdx.x);
        pg8::EpiRes<1> E{nullptr, (const bf16*)(ws + WS_H1B), nullptr, (bf16*)(ws + WS_H2B), DM, ctl + CF_SS3};
        pg8::gemm_phase(ldsl, g, S, E);
    }
    SEAM(7);
    if (IN(8)) { final_pass(p, G); }
#undef IN
#undef SEAM
}

constexpr int N_PHASES = 9;

extern "C" void kernel_launch(void* const* d_in, const int* in_sizes, int n_in, void* d_out, int out_size, void* d_ws, size_t ws_size, hipStream_t stream) {
    static int grid = 0;
    if (grid == 0) {
        if (n_in != 18 || in_sizes[0] != T * DM || out_size != T * DM || ws_size < WS_END) { fprintf(stderr, "kernel_launch: unexpected shapes / workspace (n_in %d, ws %zu, need %zu)\n", n_in, ws_size, (size_t)WS_END); grid = -1; return; }
        int dev = 0, cus = 0, per_cu = 0;
        hipGetDevice(&dev); hipDeviceGetAttribute(&cus, hipDeviceAttributeMultiprocessorCount, dev);
        if (hipFuncSetAttribute((const void*)fwd_kernel, hipFuncAttributeMaxDynamicSharedMemorySize, LDS_BYTES) != hipSuccess) { fprintf(stderr, "kernel_launch: hipFuncSetAttribute failed\n"); grid = -1; return; }
        hipOccupancyMaxActiveBlocksPerMultiprocessor(&per_cu, (const void*)fwd_kernel, NTHR, LDS_BYTES);
        (void)hipGetLastError();
        if (per_cu < 1) { fprintf(stderr, "kernel_launch: occupancy query says %d blocks per CU\n", per_cu); per_cu = 1; }
        grid = cus > 0 ? cus : 256;
    }
    if (grid < 0) return;
    Params p{};
    p.x = (const float*)d_in[0]; p.pos = (const int*)d_in[1]; p.mix_g = (const float*)d_in[2]; p.w_in = (const float*)d_in[3]; p.qn_g = (const float*)d_in[4];
    p.w_uq = (const float*)d_in[5]; p.kvn_g = (const float*)d_in[6]; p.w_ukv = (const float*)d_in[7]; p.attn_g = (const float*)d_in[8]; p.lb = (const float*)d_in[9];
    p.hg_g = (const float*)d_in[10]; p.w_out = (const float*)d_in[11]; p.ffn_g = (const float*)d_in[12]; p.w_up = (const float*)d_in[13]; p.conv_w = (const float*)d_in[14];
    p.conv_b = (const float*)d_in[15]; p.w_down = (const float*)d_in[16]; p.fin_g = (const float*)d_in[17]; p.out = (float*)d_out; p.ws = (unsigned char*)d_ws;
#if ONE_LAUNCH
    p.ph_lo = 0; p.ph_hi = N_PHASES;
    if (hipMemsetAsync((char*)d_ws + WS_BAR, 0, 16384, stream) != hipSuccess) { fprintf(stderr, "kernel_launch: hipMemsetAsync failed\n"); return; }
    void* args[] = {&p};
    hipError_t e = hipLaunchCooperativeKernel((const void*)fwd_kernel, dim3(grid), dim3(NTHR), args, LDS_BYTES, stream);
    if (e != hipSuccess) fprintf(stderr, "cooperative launch failed: %s (grid %d)\n", hipGetErrorString(e), grid);
#else
    for (int ph = 0; ph < N_PHASES; ++ph) { p.ph_lo = ph; p.ph_hi = ph + 1; hipLaunchKernelGGL(fwd_kernel, dim3(grid), dim3(NTHR), LDS_BYTES, stream, p); }
#endif
}
```
